# Optimizing an MI355X kernel written in HIP

```python
import jax, jax.numpy as jnp
from jax import lax
import numpy as np

D_MODEL = 1024
BATCH = 8
SEQ = 4096
DEPTH = 1

MLA_HEADS = 8
MLA_NOPE_DIM = 64
MLA_ROPE_DIM = 32
MLA_V_DIM = 64
MLA_Q_RANK = 256
MLA_KV_RANK = 128
MOBA_HEADS = 8
MOBA_HEAD_DIM = 64
MOBA_BLOCK = 256
MOBA_TOPK = 3
MOBA_Q_CHUNK = 32
D_FF = 4 * D_MODEL
ROPE_THETA = 10000.0
NORM_EPS = 1e-6
Q_BLOCK = 128
NEG_INF = -1e30

MLA_WIDTH = MLA_HEADS * MLA_V_DIM
MOBA_WIDTH = MOBA_HEADS * MOBA_HEAD_DIM
MIX_WIDTH = MLA_WIDTH + MOBA_WIDTH
IN_COLS = MLA_Q_RANK + MLA_KV_RANK + MLA_ROPE_DIM + 3 * MOBA_WIDTH

kernel_name = 'hymba_mla_moba_sandwich_layer'


def rms_norm(x, g):
    xf = x.astype(jnp.float32)
    y = xf * lax.rsqrt(jnp.mean(xf * xf, axis=-1, keepdims=True) + NORM_EPS)
    return (y * g.astype(jnp.float32)).astype(x.dtype)


def rope(x, pos):
    half = x.shape[-1] // 2
    inv_freq = 1.0 / (ROPE_THETA ** (jnp.arange(half, dtype=jnp.float32) / half))
    ang = pos.astype(jnp.float32)[:, None] * inv_freq[None, :]
    cos = jnp.cos(ang).astype(x.dtype)
    sin = jnp.sin(ang).astype(x.dtype)
    x1 = x[..., :half]
    x2 = x[..., half:]
    return jnp.concatenate([x1 * cos - x2 * sin, x2 * cos + x1 * sin], axis=-1)


def causal_dense_attention(q, k, v, scale):
    B, H, S, Dq = q.shape
    Dv = v.shape[-1]
    nq = S // Q_BLOCK
    qb = q.reshape(B, H, nq, Q_BLOCK, Dq).transpose(2, 0, 1, 3, 4)
    k_pos = jnp.arange(S)

    def one(args):
        q_blk, start = args
        s = jnp.einsum('bhqd,bhkd->bhqk', q_blk, k).astype(jnp.float32) * scale
        q_pos = start + jnp.arange(Q_BLOCK)
        s = jnp.where(k_pos[None, :] <= q_pos[:, None], s, NEG_INF)
        p = jax.nn.softmax(s, axis=-1).astype(v.dtype)
        return jnp.einsum('bhqk,bhkd->bhqd', p, v)

    out = lax.map(one, (qb, jnp.arange(nq, dtype=jnp.int32) * Q_BLOCK))
    return out.transpose(1, 2, 0, 3, 4).reshape(B, H, S, Dv)


def mla_attention(c_q, c_kv, k_r, q_norm_g, w_q_up, kv_norm_g, w_kv_up, pos):
    B, S, _ = c_q.shape
    q = (rms_norm(c_q, q_norm_g) @ w_q_up).reshape(B, S, MLA_HEADS, MLA_NOPE_DIM + MLA_ROPE_DIM)
    q = q.transpose(0, 2, 1, 3)
    q_nope = q[..., :MLA_NOPE_DIM]
    q_rope = rope(q[..., MLA_NOPE_DIM:], pos)
    kv = (rms_norm(c_kv, kv_norm_g) @ w_kv_up).reshape(B, S, MLA_HEADS, MLA_NOPE_DIM + MLA_V_DIM)
    kv = kv.transpose(0, 2, 1, 3)
    k_nope = kv[..., :MLA_NOPE_DIM]
    v = kv[..., MLA_NOPE_DIM:]
    k_rope = rope(k_r[:, None, :, :], pos)
    k_rope = jnp.broadcast_to(k_rope, (B, MLA_HEADS, S, MLA_ROPE_DIM))
    q_full = jnp.concatenate([q_nope, q_rope], axis=-1)
    k_full = jnp.concatenate([k_nope, k_rope], axis=-1)
    scale = (MLA_NOPE_DIM + MLA_ROPE_DIM) ** -0.5
    return causal_dense_attention(q_full, k_full, v, scale)


def moba_attention(q, k, v):
    B, H, S, D = q.shape
    nb = -(-S // MOBA_BLOCK)
    s_pad = nb * MOBA_BLOCK
    pad = ((0, 0), (0, 0), (0, s_pad - S), (0, 0))
    k_p = jnp.pad(k, pad)
    v_p = jnp.pad(v, pad)
    k_blocks = k_p.reshape(B, H, nb, MOBA_BLOCK, D)
    v_blocks = v_p.reshape(B, H, nb, MOBA_BLOCK, D)
    k_mean = jnp.mean(k_blocks.astype(jnp.float32), axis=3)
    top = min(MOBA_TOPK, nb)
    n_chunks = S // MOBA_Q_CHUNK
    qc = q.reshape(B, H, n_chunks, MOBA_Q_CHUNK, D).transpose(2, 0, 1, 3, 4)
    b_idx = jnp.arange(B)[:, None, None, None]
    h_idx = jnp.arange(H)[None, :, None, None]
    blk_ids = jnp.arange(nb)
    offs = jnp.arange(MOBA_BLOCK)
    scale = D ** -0.5

    def one(args):
        q_blk, start = args
        cur = start // MOBA_BLOCK
        gate = jnp.einsum('bhqd,bhnd->bhqn', q_blk.astype(jnp.float32), k_mean)
        gate = jnp.where(blk_ids < cur, gate, NEG_INF)
        _, sel = lax.top_k(gate, top)
        sel_valid = sel < cur
        k_sel = k_blocks[b_idx, h_idx, sel]
        v_sel = v_blocks[b_idx, h_idx, sel]
        s_sel = jnp.einsum('bhqd,bhqnkd->bhqnk', q_blk, k_sel).astype(jnp.float32) * scale
        s_sel = jnp.where(sel_valid[..., None], s_sel, NEG_INF)
        s_sel = s_sel.reshape(B, H, MOBA_Q_CHUNK, top * MOBA_BLOCK)
        k_own = lax.dynamic_slice_in_dim(k_p, cur * MOBA_BLOCK, MOBA_BLOCK, axis=2)
        v_own = lax.dynamic_slice_in_dim(v_p, cur * MOBA_BLOCK, MOBA_BLOCK, axis=2)
        s_own = jnp.einsum('bhqd,bhkd->bhqk', q_blk, k_own).astype(jnp.float32) * scale
        q_pos = start + jnp.arange(MOBA_Q_CHUNK)
        k_pos = cur * MOBA_BLOCK + offs
        s_own = jnp.where(k_pos[None, :] <= q_pos[:, None], s_own, NEG_INF)
        p = jax.nn.softmax(jnp.concatenate([s_sel, s_own], axis=-1), axis=-1).astype(v.dtype)
        p_sel = p[..., :top * MOBA_BLOCK].reshape(B, H, MOBA_Q_CHUNK, top, MOBA_BLOCK)
        p_own = p[..., top * MOBA_BLOCK:]
        return (jnp.einsum('bhqnk,bhqnkd->bhqd', p_sel, v_sel)
                + jnp.einsum('bhqk,bhkd->bhqd', p_own, v_own))

    out = lax.map(one, (qc, jnp.arange(n_chunks, dtype=jnp.int32) * MOBA_Q_CHUNK))
    return out.transpose(1, 2, 0, 3, 4).reshape(B, H, S, D)


def setup_inputs(seed: int = 0) -> dict:
    key = jax.random.key(seed)
    ks = jax.random.split(key, 14)

    def nrm(k, shape, scale):
        return jax.random.normal(k, shape, jnp.float32) * scale

    def gain(k, n):
        return 1.0 + 0.05 * jax.random.normal(k, (DEPTH, n), jnp.float32)

    return {
        'x': nrm(ks[0], (BATCH, SEQ, D_MODEL), 1.0),
        'attn_pre_g': gain(ks[1], D_MODEL),
        'w_in': nrm(ks[2], (DEPTH, D_MODEL, IN_COLS), D_MODEL ** -0.5),
        'mla_q_norm_g': gain(ks[3], MLA_Q_RANK),
        'w_mla_q_up': nrm(ks[4], (DEPTH, MLA_Q_RANK, MLA_HEADS * (MLA_NOPE_DIM + MLA_ROPE_DIM)), MLA_Q_RANK ** -0.5),
        'mla_kv_norm_g': gain(ks[5], MLA_KV_RANK),
        'w_mla_kv_up': nrm(ks[6], (DEPTH, MLA_KV_RANK, MLA_HEADS * (MLA_NOPE_DIM + MLA_V_DIM)), MLA_KV_RANK ** -0.5),
        'w_out': nrm(ks[7], (DEPTH, MIX_WIDTH, D_MODEL), MIX_WIDTH ** -0.5),
        'attn_post_g': gain(ks[8], D_MODEL),
        'mlp_pre_g': gain(ks[9], D_MODEL),
        'w_up': nrm(ks[10], (DEPTH, D_MODEL, D_FF), D_MODEL ** -0.5),
        'w_down': nrm(ks[11], (DEPTH, D_FF, D_MODEL), D_FF ** -0.5),
        'mlp_post_g': gain(ks[12], D_MODEL),
    }


def reference(x, attn_pre_g, w_in, mla_q_norm_g, w_mla_q_up, mla_kv_norm_g, w_mla_kv_up,
              w_out, attn_post_g, mlp_pre_g, w_up, w_down, mlp_post_g):
    B, S, _ = x.shape
    pos = jnp.arange(S, dtype=jnp.int32)
    s1 = MLA_Q_RANK
    s2 = s1 + MLA_KV_RANK
    s3 = s2 + MLA_ROPE_DIM
    h = x
    for l in range(DEPTH):
        u = rms_norm(h, attn_pre_g[l])
        proj = u @ w_in[l]
        c_q = proj[..., :s1]
        c_kv = proj[..., s1:s2]
        k_r = proj[..., s2:s3]
        moba_qkv = proj[..., s3:].reshape(B, S, 3, MOBA_HEADS, MOBA_HEAD_DIM)
        moba_qkv = moba_qkv.transpose(2, 0, 3, 1, 4)
        mla_o = mla_attention(c_q, c_kv, k_r, mla_q_norm_g[l], w_mla_q_up[l],
                              mla_kv_norm_g[l], w_mla_kv_up[l], pos)
        moba_o = moba_attention(rope(moba_qkv[0], pos), rope(moba_qkv[1], pos), moba_qkv[2])
        mix = jnp.concatenate([
            mla_o.transpose(0, 2, 1, 3).reshape(B, S, MLA_WIDTH),
            moba_o.transpose(0, 2, 1, 3).reshape(B, S, MOBA_WIDTH)], axis=-1)
        h = h + rms_norm(mix @ w_out[l], attn_post_g[l])
        u = rms_norm(h, mlp_pre_g[l])
        a = jnp.square(jax.nn.relu(u @ w_up[l]))
        h = h + rms_norm(a @ w_down[l], mlp_post_g[l])
    return h
```

```cpp
#include <hip/hip_runtime.h>
#include <cstdint>
#include <cstdio>
#include <cmath>

constexpr int NB = 8, SEQ = 4096, DM = 1024, M = NB * SEQ;
constexpr int NIN = 1952, NINP = 2048, FF = 4096;
constexpr int C_CQ = 0, C_CKV = 256, C_KR = 384, C_MQ = 416, C_MK = 928, C_MV = 1440;
constexpr float EPS = 1e-6f;
constexpr float LOG2E = 1.4426950408889634f;
constexpr float C2M = 0.125f * LOG2E;
constexpr float C2A = 0.10206207261596577f * LOG2E;

typedef _Float16 h16;
typedef unsigned short u16;

constexpr size_t MiB = 1u << 20;
constexpr size_t WS_CTL = 0, CTL_ZERO_BYTES = 1 * MiB;
constexpr size_t WS_WIN = 2 * MiB;
constexpr size_t WS_WQU = 6 * MiB;
constexpr size_t WS_WKVU = 6 * MiB + 512 * 1024;
constexpr size_t WS_WOUT = 7 * MiB;
constexpr size_t WS_WUP = 9 * MiB;
constexpr size_t WS_WDN = 17 * MiB;
constexpr size_t WS_ROPE_M = 25 * MiB;
constexpr size_t WS_ROPE_A = 26 * MiB;
constexpr size_t WS_KMEAN = 27 * MiB;
constexpr size_t WS_RSQ = 28 * MiB;
constexpr size_t WS_XN = 32 * MiB;
constexpr size_t WS_QM = 96 * MiB, WS_KM = 128 * MiB, WS_VM = 160 * MiB;
constexpr size_t WS_CQ = 192 * MiB;
constexpr size_t WS_CKV = 208 * MiB;
constexpr size_t WS_KR = 216 * MiB;
constexpr size_t WS_QN = 220 * MiB;
constexpr size_t WS_QR = 252 * MiB;
constexpr size_t WS_KN = 268 * MiB;
constexpr size_t WS_VA = 300 * MiB;
constexpr size_t WS_MIX = 332 * MiB;
constexpr size_t WS_A2 = 96 * MiB;
constexpr size_t WS_T_OUT = 96 * MiB;
constexpr size_t WS_T_DN = 352 * MiB;
constexpr size_t WS_NEED = 480 * MiB;
constexpr int CW_BAR = 4096;

__device__ __forceinline__ unsigned f2bf(float f) { unsigned u = __builtin_bit_cast(unsigned, f); return (u + 0x7fffu + ((u >> 16) & 1u)) >> 16; }
__device__ __forceinline__ float bf2f(u16 b) { return __builtin_bit_cast(float, (unsigned)b << 16); }
typedef _Float16 h16x2_t __attribute__((ext_vector_type(2)));
__device__ __forceinline__ unsigned pk_h16(float lo, float hi) { h16x2_t v = {(h16)lo, (h16)hi}; return __builtin_bit_cast(unsigned, v); }
__device__ __forceinline__ unsigned pk_bf16(float lo, float hi) { unsigned r; asm volatile("v_cvt_pk_bf16_f32 %0, %1, %2" : "=v"(r) : "v"(lo), "v"(hi)); return r; }

__device__ __forceinline__ float wave_sum(float v) {
#pragma unroll
    for (int o = 1; o < 64; o <<= 1) v += __shfl_xor(v, o);
    return v;
}
__device__ __forceinline__ float block_sum256(float v, float* scr) {
    v = wave_sum(v);
    __syncthreads();
    if ((threadIdx.x & 63) == 0) scr[threadIdx.x >> 6] = v;
    __syncthreads();
    return (scr[0] + scr[1]) + (scr[2] + scr[3]);
}

__host__ __device__ __forceinline__ int src_col_in(int p) {
    const int tile = p >> 8, q = p & 255, bj = q >> 7, wc = (q >> 5) & 3, fq = (q >> 3) & 3, n = (q >> 2) & 1, j = q & 3;
    if (tile < 4) { const int head = (tile & 1) * 4 + 2 * bj + (wc >> 1), d = 32 * n + 16 * (wc & 1) + 4 * fq + j; return (tile < 2 ? C_MQ : C_MK) + head * 64 + d; }
    if (tile < 6) return C_MV + (tile - 4) * 256 + q;
    if (tile == 6) return C_CQ + q;
    if (q < 128) return C_CKV + q;
    if (q < 160) return C_KR + 16 * n + 4 * fq + j;
    return -1;
}
__host__ __device__ __forceinline__ int src_col_qu(int p) {
    if (p < 512) return (p >> 6) * 96 + (p & 63);
    const int q = p - 512, bj = q >> 7, wc = (q >> 5) & 3, fq = (q >> 3) & 3, n = (q >> 2) & 1, j = q & 3;
    return (4 * bj + wc) * 96 + 64 + 16 * n + 4 * fq + j;
}
__host__ __device__ __forceinline__ int src_col_kvu(int p) { return p < 512 ? (p >> 6) * 128 + (p & 63) : ((p - 512) >> 6) * 128 + 64 + (p & 63); }


namespace pg8 {
#define PG8_LAS __attribute__((address_space(3)))
typedef short bf16x8 __attribute__((ext_vector_type(8)));
typedef _Float16 f16x8 __attribute__((ext_vector_type(8)));
typedef float f32x4 __attribute__((ext_vector_type(4)));
typedef unsigned u32x4 __attribute__((ext_vector_type(4)));
typedef unsigned u32x2 __attribute__((ext_vector_type(2)));
constexpr int BM = 256, BK = 64, HALF = 128, HTB = HALF * BK * 2  , STAGE_BYTES = 8 * HTB, NXCD = 8, WGM = 8;

__host__ __device__ __forceinline__ int lds_byte(int r, int c) { const int st = (r >> 4) * 2 + (c >> 5), rr = r & 15, cc = c & 31, ob = rr * 64 + cc * 2; return st * 1024 + (ob ^ (((ob >> 9) & 1) << 5)); }
__host__ __device__ __forceinline__ void stage_rc(int b, int& R, int& C) { const int st = b / 1024, sb = b % 1024, swz = sb ^ (((sb >> 9) & 1) << 5); R = (st >> 1) * 16 + swz / 64; C = (st & 1) * 32 + (swz % 64) / 2; }
__host__ __device__ __forceinline__ int perm32(int rho) { const int n = rho >> 4, i = rho & 15; return 8 * (i >> 2) + 4 * n + (i & 3); }

struct Unit { int pm, pn; };
struct Gemm { const u16* A; const u16* Bt; int M, N, K; };

struct StaticOrder {
    int nM, nN, nwg, G, c;
    __host__ __device__ void init(int M_, int N_, int G_, int c_) { nM = M_ / BM; nN = N_ / BM; nwg = nM * nN; G = G_; c = c_; }
    __host__ __device__ bool next(int i, Unit& u) const {
        const long L = (long)i * G + c; if (L >= nwg) return false;
        int wgid = (int)L; { const int q = nwg / NXCD, r = nwg % NXCD, xcd = wgid % NXCD, off = wgid / NXCD; wgid = (xcd < r ? xcd * (q + 1) : r * (q + 1) + (xcd - r) * q) + off; }
        const int nig = WGM * nN, gid = wgid / nig, fm = gid * WGM, gsz = (nM - fm) < WGM ? (nM - fm) : WGM;
        u.pm = fm + ((wgid % nig) % gsz); u.pn = (wgid % nig) / gsz; return true;
    }
    __device__ __forceinline__ void a_ready(const Unit&) const {}
    __device__ __forceinline__ void done(const Unit&) const {}
};

__device__ __forceinline__ u32x4 pack8_h16(const f32x4& v0, const f32x4& v1, float s) {
    u32x4 w; w.x = pk_h16(v0[0] * s, v0[1] * s); w.y = pk_h16(v0[2] * s, v0[3] * s); w.z = pk_h16(v1[0] * s, v1[1] * s); w.w = pk_h16(v1[2] * s, v1[3] * s); return w; }

struct EpiP1 {
    static constexpr bool PERM = true, AFTER_DRAIN = false;
    h16 *QM, *KM, *VM, *CQ, *CKV, *KR; float *kmean, *rsq_q, *rsq_kv; const float2 *ropem, *ropea;
    __device__ __forceinline__ void operator()(const f32x4 (&acc)[2][2][4][2], const Unit& u, int wr, int wc, int fr, int fq) const {
        const int pn = u.pn, row0 = u.pm * BM + wr * 64 + fr;
        if (pn < 4) {
            const bool isq = pn < 2; h16* dst = isq ? QM : KM; const float sc = isq ? C2M : 1.f;
            const int hbase = (pn & 1) * 4 + (wc >> 1), dlo = 16 * (wc & 1) + 4 * fq;
            f32x4 ks[2][2];
#pragma unroll
            for (int bj = 0; bj < 2; ++bj) { ks[bj][0] = (f32x4){0.f, 0.f, 0.f, 0.f}; ks[bj][1] = (f32x4){0.f, 0.f, 0.f, 0.f}; }
#pragma unroll
            for (int ai = 0; ai < 2; ++ai)
#pragma unroll
                for (int m = 0; m < 4; ++m) {
                    const int r = row0 + ai * HALF + m * 16, pos = r & (SEQ - 1);
                    const f32x4* tp = (const f32x4*)(ropem + pos * 32 + dlo); const f32x4 t0 = tp[0], t1 = tp[1];
                    const f32x4 cs = {t0[0], t0[2], t1[0], t1[2]}, sn = {t0[1], t0[3], t1[1], t1[3]};
#pragma unroll
                    for (int bj = 0; bj < 2; ++bj) {
                        const f32x4 a = acc[ai][bj][m][0], b = acc[ai][bj][m][1];
                        const f32x4 lo = a * cs - b * sn, hi = b * cs + a * sn;
                        ks[bj][0] += lo; ks[bj][1] += hi;
                        h16* p = dst + (size_t)r * 512 + (hbase + 2 * bj) * 64 + dlo;
                        u32x2 w0, w1; w0.x = pk_h16(lo[0] * sc, lo[1] * sc); w0.y = pk_h16(lo[2] * sc, lo[3] * sc); w1.x = pk_h16(hi[0] * sc, hi[1] * sc); w1.y = pk_h16(hi[2] * sc, hi[3] * sc);
                        *(u32x2*)p = w0; *(u32x2*)(p + 32) = w1;
                    }
                }
            if (!isq) {
#pragma unroll
                for (int bj = 0; bj < 2; ++bj)
#pragma unroll
                    for (int n = 0; n < 2; ++n) {
                        f32x4 s = ks[bj][n];
#pragma unroll
                        for (int o = 1; o < 16; o <<= 1) { s[0] += __shfl_xor(s[0], o); s[1] += __shfl_xor(s[1], o); s[2] += __shfl_xor(s[2], o); s[3] += __shfl_xor(s[3], o); }
                        if (fr == 0) *(f32x4*)(kmean + ((size_t)wr * (NB * 16) + u.pm) * 512 + (hbase + 2 * bj) * 64 + dlo + 32 * n) = s * (1.f / 256.f);
                    }
            }
        } else if (pn < 6) {
#pragma unroll
            for (int ai = 0; ai < 2; ++ai)
#pragma unroll
                for (int m = 0; m < 4; ++m) { h16* p = VM + (size_t)(row0 + ai * HALF + m * 16) * 512 + (pn - 4) * 256 + wc * 32 + 8 * fq;
#pragma unroll
                    for (int bj = 0; bj < 2; ++bj) *(u32x4*)(p + bj * HALF) = pack8_h16(acc[ai][bj][m][0], acc[ai][bj][m][1], 1.f); }
        } else if (pn == 6) {
#pragma unroll
            for (int ai = 0; ai < 2; ++ai)
#pragma unroll
                for (int m = 0; m < 4; ++m) { const int r = row0 + ai * HALF + m * 16; h16* p = CQ + (size_t)r * 256 + wc * 32 + 8 * fq; float ss = 0.f;
#pragma unroll
                    for (int bj = 0; bj < 2; ++bj) { const f32x4 v0 = acc[ai][bj][m][0], v1 = acc[ai][bj][m][1]; *(u32x4*)(p + bj * HALF) = pack8_h16(v0, v1, 1.f);
                        ss += (v0[0] * v0[0] + v0[1] * v0[1]) + (v0[2] * v0[2] + v0[3] * v0[3]) + (v1[0] * v1[0] + v1[1] * v1[1]) + (v1[2] * v1[2] + v1[3] * v1[3]); }
                    ss += __shfl_xor(ss, 16); ss += __shfl_xor(ss, 32);
                    if (fq == 0) rsq_q[(size_t)r * 4 + wc] = ss; }
        } else {
#pragma unroll
            for (int ai = 0; ai < 2; ++ai)
#pragma unroll
                for (int m = 0; m < 4; ++m) { const int r = row0 + ai * HALF + m * 16, pos = r & (SEQ - 1);
                    const f32x4 v0 = acc[ai][0][m][0], v1 = acc[ai][0][m][1]; *(u32x4*)(CKV + (size_t)r * 128 + wc * 32 + 8 * fq) = pack8_h16(v0, v1, 1.f);
                    float ss = (v0[0] * v0[0] + v0[1] * v0[1]) + (v0[2] * v0[2] + v0[3] * v0[3]) + (v1[0] * v1[0] + v1[1] * v1[1]) + (v1[2] * v1[2] + v1[3] * v1[3]);
                    ss += __shfl_xor(ss, 16); ss += __shfl_xor(ss, 32);
                    if (fq == 0) rsq_kv[(size_t)r * 4 + wc] = ss;
                    if (wc == 0) { const f32x4* tp = (const f32x4*)(ropea + pos * 16 + 4 * fq); const f32x4 t0 = tp[0], t1 = tp[1];
                        const f32x4 cs = {t0[0], t0[2], t1[0], t1[2]}, sn = {t0[1], t0[3], t1[1], t1[3]};
                        const f32x4 a = acc[ai][1][m][0], b = acc[ai][1][m][1]; const f32x4 lo = a * cs - b * sn, hi = b * cs + a * sn;
                        h16* p = KR + (size_t)r * 32 + 4 * fq; u32x2 w0, w1; w0.x = pk_h16(lo[0], lo[1]); w0.y = pk_h16(lo[2], lo[3]); w1.x = pk_h16(hi[0], hi[1]); w1.y = pk_h16(hi[2], hi[3]);
                        *(u32x2*)p = w0; *(u32x2*)(p + 16) = w1; } }
        }
    }
};
struct EpiQU {
    static constexpr bool PERM = true, AFTER_DRAIN = false;
    h16 *QN, *QR; const float* rsq_q; const float2* ropea;
    __device__ __forceinline__ void operator()(const f32x4 (&acc)[2][2][4][2], const Unit& u, int wr, int wc, int fr, int fq) const {
        const int pn = u.pn, row0 = u.pm * BM + wr * 64 + fr;
#pragma unroll
        for (int ai = 0; ai < 2; ++ai)
#pragma unroll
            for (int m = 0; m < 4; ++m) { const int r = row0 + ai * HALF + m * 16, pos = r & (SEQ - 1);
                const f32x4 pr = *(const f32x4*)(rsq_q + (size_t)r * 4); const float rq = C2A / sqrtf(((pr[0] + pr[1]) + (pr[2] + pr[3])) * (1.f / 256.f) + EPS);
                if (pn < 2) { h16* p = QN + (size_t)r * 512 + pn * 256 + wc * 32 + 8 * fq;
#pragma unroll
                    for (int bj = 0; bj < 2; ++bj) *(u32x4*)(p + bj * HALF) = pack8_h16(acc[ai][bj][m][0], acc[ai][bj][m][1], rq);
                } else { const f32x4* tp = (const f32x4*)(ropea + pos * 16 + 4 * fq); const f32x4 t0 = tp[0], t1 = tp[1];
                    const f32x4 cs = {t0[0], t0[2], t1[0], t1[2]}, sn = {t0[1], t0[3], t1[1], t1[3]};
#pragma unroll
                    for (int bj = 0; bj < 2; ++bj) { const f32x4 a = acc[ai][bj][m][0], b = acc[ai][bj][m][1]; const f32x4 lo = (a * cs - b * sn) * rq, hi = (b * cs + a * sn) * rq;
                        h16* p = QR + (size_t)r * 256 + (4 * bj + wc) * 32 + 4 * fq; u32x2 w0, w1; w0.x = pk_h16(lo[0], lo[1]); w0.y = pk_h16(lo[2], lo[3]); w1.x = pk_h16(hi[0], hi[1]); w1.y = pk_h16(hi[2], hi[3]);
                        *(u32x2*)p = w0; *(u32x2*)(p + 16) = w1; } } }
    }
};
struct EpiKVU {
    static constexpr bool PERM = true, AFTER_DRAIN = false;
    h16 *KN, *VA; const float* rsq_kv;
    __device__ __forceinline__ void operator()(const f32x4 (&acc)[2][2][4][2], const Unit& u, int wr, int wc, int fr, int fq) const {
        const int pn = u.pn, row0 = u.pm * BM + wr * 64 + fr; h16* dst = (pn < 2 ? KN : VA) + (pn & 1) * 256 + wc * 32 + 8 * fq;
#pragma unroll
        for (int ai = 0; ai < 2; ++ai)
#pragma unroll
            for (int m = 0; m < 4; ++m) { const int r = row0 + ai * HALF + m * 16;
                const f32x4 pr = *(const f32x4*)(rsq_kv + (size_t)r * 4); const float rk = 1.0f / sqrtf(((pr[0] + pr[1]) + (pr[2] + pr[3])) * (1.f / 128.f) + EPS);
                h16* p = dst + (size_t)r * 512;
#pragma unroll
                for (int bj = 0; bj < 2; ++bj) *(u32x4*)(p + bj * HALF) = pack8_h16(acc[ai][bj][m][0], acc[ai][bj][m][1], rk); }
    }
};
struct EpiF32 {
    static constexpr bool PERM = false, AFTER_DRAIN = false;
    float* C; int ldc;
    __device__ __forceinline__ void operator()(const f32x4 (&acc)[2][2][4][2], const Unit& u, int wr, int wc, int fr, int fq) const {
        const int row0 = u.pm * BM + wr * 64 + fr, col0 = u.pn * BM + wc * 32 + 4 * fq;
#pragma unroll
        for (int ai = 0; ai < 2; ++ai)
#pragma unroll
            for (int m = 0; m < 4; ++m) { float* p = C + (size_t)(row0 + ai * HALF + m * 16) * ldc + col0;
#pragma unroll
                for (int bj = 0; bj < 2; ++bj)
#pragma unroll
                    for (int n = 0; n < 2; ++n) *(f32x4*)(p + bj * HALF + n * 16) = acc[ai][bj][m][n]; }
    }
};
struct EpiRelu2 {
    static constexpr bool PERM = true, AFTER_DRAIN = false;
    u16* O; int ldc;
    __device__ __forceinline__ void operator()(const f32x4 (&acc)[2][2][4][2], const Unit& u, int wr, int wc, int fr, int fq) const {
        const int row0 = u.pm * BM + wr * 64 + fr, col0 = u.pn * BM + wc * 32 + 8 * fq;
#pragma unroll
        for (int ai = 0; ai < 2; ++ai)
#pragma unroll
            for (int m = 0; m < 4; ++m) { u16* p = O + (size_t)(row0 + ai * HALF + m * 16) * ldc + col0;
#pragma unroll
                for (int bj = 0; bj < 2; ++bj) { f32x4 v0 = acc[ai][bj][m][0], v1 = acc[ai][bj][m][1];
#pragma unroll
                    for (int e = 0; e < 4; ++e) { v0[e] = v0[e] > 0.f ? v0[e] * v0[e] : 0.f; v1[e] = v1[e] > 0.f ? v1[e] * v1[e] : 0.f; }
                    u32x4 w; w.x = pk_bf16(v0[0], v0[1]); w.y = pk_bf16(v0[2], v0[3]); w.z = pk_bf16(v1[0], v1[1]); w.w = pk_bf16(v1[2], v1[3]);
                    *(u32x4*)(p + bj * HALF) = w; } }
    }
};


template <bool F16> __device__ __forceinline__ f32x4 mma16(bf16x8 a, bf16x8 b, f32x4 c) {
    if constexpr (F16) return __builtin_amdgcn_mfma_f32_16x16x32_f16(__builtin_bit_cast(f16x8, a), __builtin_bit_cast(f16x8, b), c, 0, 0, 0);
    else return __builtin_amdgcn_mfma_f32_16x16x32_bf16(a, b, c, 0, 0, 0);
}
template <bool F16, class Epi, class Sched, bool ALIGN_EPI = false, bool SP2 = false>
__device__ __forceinline__ void gemm_phase(PG8_LAS unsigned char* lds, const Gemm g, const Sched& S, const Epi& E) {
    int tid_ = threadIdx.x; asm volatile("" : "+v"(tid_));
    const int tid = tid_, wid = __builtin_amdgcn_readfirstlane(tid >> 6), lane = tid & 63, wr = wid >> 2, wc = wid & 3, fr = lane & 15, fq = lane >> 4;
    const int K = g.K, nt = K / BK;
    unsigned voffA[2], voffB[2];
#pragma unroll
    for (int i = 0; i < 2; ++i) { int R, C; stage_rc(tid * 16 + i * 8192, R, C); const int Rb = Epi::PERM ? ((R & ~31) + perm32(R & 31)) : R;
        voffA[i] = (unsigned)(R * K + C) * 2u; voffB[i] = (unsigned)(Rb * K + C) * 2u; }
    const size_t kstep = (size_t)(BK * 2);
    const size_t hstep = (size_t)HALF * K * 2;
    const size_t tstep = 2 * hstep;
    const unsigned ldsw = (unsigned)wid * 1024u;
    const int aoff = lds_byte(wr * 64 + fr, fq * 8), boff = lds_byte(wc * 32 + fr, fq * 8);
#define PG8_SA(b, h) (((b) * 2 + (h)) * HTB)
#define PG8_SB(b, h) ((4 + (b) * 2 + (h)) * HTB)
#define PG8_STAGE(bufoff, gbase, voff) do { _Pragma("unroll") for (int _i = 0; _i < 2; ++_i) \
        __builtin_amdgcn_global_load_lds((const unsigned*)((const char*)(gbase) + (voff)[_i]), (PG8_LAS unsigned*)(lds + (bufoff) + ldsw + _i * 8192), 16, 0, 0); } while (0)
#define PG8_LDA(dst, b, h) do { _Pragma("unroll") for (int m = 0; m < 4; ++m) _Pragma("unroll") for (int k = 0; k < 2; ++k) dst[m][k] = *(const PG8_LAS bf16x8*)(lds + PG8_SA(b, h) + aoff + m * 2048 + k * 1024); } while (0)
#define PG8_LDB(dst, b, h) do { _Pragma("unroll") for (int n = 0; n < 2; ++n) _Pragma("unroll") for (int k = 0; k < 2; ++k) dst[n][k] = *(const PG8_LAS bf16x8*)(lds + PG8_SB(b, h) + boff + n * 2048 + k * 1024); } while (0)
#define PG8_MMA(ai, bj, At, Bt) do { __builtin_amdgcn_s_setprio(1); _Pragma("unroll") for (int m = 0; m < 4; ++m) _Pragma("unroll") for (int n = 0; n < 2; ++n) _Pragma("unroll") for (int k = 0; k < 2; ++k) \
        acc[ai][bj][m][n] = mma16<F16>(Bt[n][k], At[m][k], acc[ai][bj][m][n]); __builtin_amdgcn_s_setprio(0); } while (0)
#define PG8_WAIT_V(n) asm volatile("s_waitcnt vmcnt(" #n ")" ::: "memory")
#define PG8_WAIT_L(n) asm volatile("s_waitcnt lgkmcnt(" #n ")" ::: "memory")
#define PG8_BAR __builtin_amdgcn_s_barrier()
#define PG8_SCHED __builtin_amdgcn_sched_barrier(0)
    Unit cur, nxt; int ui = 0;
    if (!S.next(0, cur)) return;
    f32x4 acc[2][2][4][2];
#pragma unroll
    for (int a = 0; a < 2; ++a)
#pragma unroll
        for (int b = 0; b < 2; ++b)
#pragma unroll
            for (int m = 0; m < 4; ++m)
#pragma unroll
                for (int n = 0; n < 2; ++n) acc[a][b][m][n] = (f32x4){0.f, 0.f, 0.f, 0.f};
    bf16x8 At[4][2], B0[2][2], B1[2][2];
    const char* cA = (const char*)g.A + (size_t)cur.pm * tstep; const char* cB = (const char*)g.Bt + (size_t)cur.pn * tstep;
    S.a_ready(cur);
    if constexpr (SP2) {
        PG8_STAGE(PG8_SB(0, 0), cB, voffB); PG8_STAGE(PG8_SB(0, 1), cB + hstep, voffB); PG8_STAGE(PG8_SA(0, 0), cA, voffA); PG8_STAGE(PG8_SA(0, 1), cA + hstep, voffA);
        if (wr == 1) PG8_BAR;
        PG8_WAIT_V(2); PG8_BAR;
        PG8_STAGE(PG8_SB(1, 0), cB + kstep, voffB); PG8_STAGE(PG8_SA(1, 0), cA + kstep, voffA); PG8_STAGE(PG8_SB(1, 1), cB + hstep + kstep, voffB);
        PG8_WAIT_V(6); PG8_BAR;
    } else {
        PG8_STAGE(PG8_SB(0, 0), cB, voffB); PG8_STAGE(PG8_SA(0, 0), cA, voffA); PG8_STAGE(PG8_SB(0, 1), cB + hstep, voffB); PG8_STAGE(PG8_SA(0, 1), cA + hstep, voffA);
        if (wr == 1) PG8_BAR;
        PG8_WAIT_V(4); PG8_BAR;
        PG8_STAGE(PG8_SB(1, 0), cB + kstep, voffB); PG8_STAGE(PG8_SA(1, 0), cA + kstep, voffA); PG8_STAGE(PG8_SB(1, 1), cB + hstep + kstep, voffB);
        PG8_WAIT_V(6); PG8_BAR;
    }
    for (;;) {
        const bool has_next = S.next(ui + 1, nxt);
        const char* nA = has_next ? (const char*)g.A + (size_t)nxt.pm * tstep : cA; const char* nB = has_next ? (const char*)g.Bt + (size_t)nxt.pn * tstep : cB;
        for (int t = 0; t < nt; t += 2) {
            const bool last = (t == nt - 2);
            const char* a1 = cA + (size_t)(t + 1) * kstep;
            const char* a2 = last ? nA : cA + (size_t)(t + 2) * kstep; const char* b2 = last ? nB : cB + (size_t)(t + 2) * kstep;
            const char* a3 = a2 + kstep; const char* b3 = b2 + kstep;
            if (last && has_next) S.a_ready(nxt);
            if constexpr (SP2) {
            PG8_LDB(B0, 0, 0); PG8_LDB(B1, 0, 1); PG8_SCHED; PG8_LDA(At, 0, 0); PG8_STAGE(PG8_SA(1, 1), a1 + hstep, voffA);
            PG8_WAIT_V(8); PG8_WAIT_L(0); PG8_BAR; PG8_MMA(0, 0, At, B0); PG8_MMA(0, 1, At, B1); PG8_BAR; PG8_SCHED;
            PG8_LDA(At, 0, 1); PG8_STAGE(PG8_SB(0, 0), b2, voffB); PG8_STAGE(PG8_SB(0, 1), b2 + hstep, voffB); PG8_STAGE(PG8_SA(0, 0), a2, voffA);
            PG8_WAIT_V(8); PG8_WAIT_L(0); PG8_BAR; PG8_MMA(1, 0, At, B0); PG8_MMA(1, 1, At, B1); PG8_BAR; PG8_SCHED;
            PG8_LDB(B0, 1, 0); PG8_LDB(B1, 1, 1); PG8_SCHED; PG8_LDA(At, 1, 0); PG8_STAGE(PG8_SA(0, 1), a2 + hstep, voffA);
            PG8_WAIT_V(8); PG8_WAIT_L(0); PG8_BAR; PG8_MMA(0, 0, At, B0); PG8_MMA(0, 1, At, B1); PG8_BAR; PG8_SCHED;
            PG8_LDA(At, 1, 1); PG8_STAGE(PG8_SB(1, 0), b3, voffB); PG8_STAGE(PG8_SB(1, 1), b3 + hstep, voffB); PG8_STAGE(PG8_SA(1, 0), a3, voffA);
            PG8_WAIT_V(8); PG8_WAIT_L(0); PG8_BAR; PG8_MMA(1, 0, At, B0); PG8_MMA(1, 1, At, B1); PG8_BAR; PG8_SCHED;
            } else {
            PG8_LDB(B0, 0, 0); PG8_SCHED; PG8_LDA(At, 0, 0); PG8_STAGE(PG8_SA(1, 1), a1 + hstep, voffA);
            PG8_WAIT_L(8); PG8_BAR; PG8_WAIT_L(0); PG8_MMA(0, 0, At, B0); PG8_BAR; PG8_SCHED;
            PG8_LDB(B1, 0, 1); PG8_STAGE(PG8_SB(0, 0), b2, voffB);
            PG8_BAR; PG8_WAIT_L(0); PG8_MMA(0, 1, At, B1); PG8_BAR;
            PG8_LDA(At, 0, 1); PG8_STAGE(PG8_SA(0, 0), a2, voffA);
            PG8_BAR; PG8_WAIT_L(0); PG8_MMA(1, 0, At, B0); PG8_BAR; PG8_SCHED;
            PG8_STAGE(PG8_SB(0, 1), b2 + hstep, voffB);
            PG8_WAIT_V(6); PG8_BAR; PG8_MMA(1, 1, At, B1); PG8_BAR;
            PG8_LDB(B0, 1, 0); PG8_SCHED; PG8_LDA(At, 1, 0); PG8_STAGE(PG8_SA(0, 1), a2 + hstep, voffA);
            PG8_WAIT_L(8); PG8_BAR; PG8_WAIT_L(0); PG8_MMA(0, 0, At, B0); PG8_BAR; PG8_SCHED;
            PG8_LDB(B1, 1, 1); PG8_STAGE(PG8_SB(1, 0), b3, voffB);
            PG8_BAR; PG8_WAIT_L(0); PG8_MMA(0, 1, At, B1); PG8_BAR;
            PG8_LDA(At, 1, 1); PG8_STAGE(PG8_SA(1, 0), a3, voffA);
            PG8_BAR; PG8_WAIT_L(0); PG8_MMA(1, 0, At, B0); PG8_BAR; PG8_SCHED;
            PG8_STAGE(PG8_SB(1, 1), b3 + hstep, voffB);
            PG8_WAIT_V(6); PG8_BAR; PG8_MMA(1, 1, At, B1); PG8_BAR;
            }
        }
        if constexpr (ALIGN_EPI) { if (wr == 0) PG8_BAR; }
        if constexpr (!Epi::AFTER_DRAIN) { E(acc, cur, wr, wc, fr, fq); S.done(cur); }
        if (!has_next) break;
#pragma unroll
        for (int a = 0; a < 2; ++a)
#pragma unroll
            for (int b = 0; b < 2; ++b)
#pragma unroll
                for (int m = 0; m < 4; ++m)
#pragma unroll
                    for (int n = 0; n < 2; ++n) acc[a][b][m][n] = (f32x4){0.f, 0.f, 0.f, 0.f};
        cur = nxt; cA = nA; cB = nB; ++ui;
        if constexpr (ALIGN_EPI) { if (wr == 1) PG8_BAR; }
    }
    PG8_WAIT_V(0);
    if constexpr (!ALIGN_EPI) { if (wr == 0) PG8_BAR; }
    PG8_BAR;
    if constexpr (Epi::AFTER_DRAIN) { E.fused(acc, cur, wr, wc, fr, fq, lds, wid, lane); S.done(cur); }
#undef PG8_SA
#undef PG8_SB
#undef PG8_STAGE
#undef PG8_LDA
#undef PG8_LDB
#undef PG8_MMA
#undef PG8_WAIT_V
#undef PG8_WAIT_L
#undef PG8_BAR
#undef PG8_SCHED
}
}


#define GAS __attribute__((address_space(1)))
#define LAS __attribute__((address_space(3)))
typedef unsigned v4u __attribute__((ext_vector_type(4)));
typedef float f32x4 __attribute__((ext_vector_type(4)));
typedef GAS unsigned gu32;
typedef GAS unsigned long long gu64;
#define RLX_AGENT __ATOMIC_RELAXED, __HIP_MEMORY_SCOPE_AGENT
#define LDS_WAIT() asm volatile("s_waitcnt lgkmcnt(0)" ::: "memory")
#define VM_WAIT() asm volatile("s_waitcnt vmcnt(0)" ::: "memory")


#define XB_TMO      128
#define XB_XCNT(j)  (256  + 64 * (j))
#define XB_XSUB(j)  (1280 + 64 * (j))
#define XB_XGEN(j)  (2304 + 64 * (j))
#define XB_TOP      3328
#define XB_TOPGEN   3392
#define XCD_BAR_WORDS 3456
#define XB_SPIN_CAP (1u << 18)

__device__ __forceinline__ unsigned xb_ld(unsigned* p)              { return __hip_atomic_load(p, __ATOMIC_RELAXED, __HIP_MEMORY_SCOPE_AGENT); }
__device__ __forceinline__ unsigned xb_add(unsigned* p, unsigned v) { return __hip_atomic_fetch_add(p, v, __ATOMIC_RELAXED, __HIP_MEMORY_SCOPE_AGENT); }
__device__ __forceinline__ unsigned xb_xcc_id() { return (unsigned)__builtin_amdgcn_s_getreg((3 << 11) | 20) & 0xFu; }
#define XB_SPIN(cond, bar) do { unsigned _sp = 0; while (cond) { __builtin_amdgcn_s_sleep(1); \
    if ((++_sp & 255u) == 0u) { if (xb_ld(&(bar)[XB_TMO])) break; if (_sp > XB_SPIN_CAP) { atomicAdd(&(bar)[XB_TMO], 1u); break; } } } } while (0)

struct XcdBarrier {
    unsigned* bar; unsigned x;
    volatile LAS unsigned* st;
};

__device__ __forceinline__ XcdBarrier xcd_barrier_post(unsigned* bar, volatile LAS unsigned* st) {
    XcdBarrier b; b.bar = bar; b.x = xb_xcc_id(); b.st = st;
    if (threadIdx.x == 0) (void)xb_add(&bar[XB_XCNT(b.x)], 1u);
    return b;
}
__device__ __forceinline__ void xcd_barrier_complete(unsigned* bar, unsigned x, unsigned& nloc, unsigned& nx) {
    const unsigned G = gridDim.x * gridDim.y * gridDim.z;
    unsigned sum, cnt, mine, sp = 0u;
    for (;;) {
        sum = 0u; cnt = 0u; mine = 0u;
#pragma unroll
        for (unsigned j = 0; j < 16; ++j) { const unsigned c = xb_ld(&bar[XB_XCNT(j)]); sum += c; cnt += (c > 0u) ? 1u : 0u; mine = (j == x) ? c : mine; }
        if (sum == G) break;
        __builtin_amdgcn_s_sleep(1);
        if ((++sp & 255u) == 0u) { if (xb_ld(&bar[XB_TMO])) break; if (sp > XB_SPIN_CAP) { atomicAdd(&bar[XB_TMO], 1u); break; } }
    }
    nloc = mine > 0u ? mine : 1u; nx = cnt > 0u ? cnt : 1u;
}

__device__ __forceinline__ void xcd_barrier(const XcdBarrier& b) {
    asm volatile("s_waitcnt vmcnt(0)" ::: "memory");
    __syncthreads();
    if (threadIdx.x == 0) {
        unsigned* bar = b.bar;
        __builtin_amdgcn_s_waitcnt(0);
        unsigned nloc = b.st[0], nx = b.st[1];
        if (nloc == 0u) { xcd_barrier_complete(bar, b.x, nloc, nx); b.st[0] = nloc; b.st[1] = nx; }
        const unsigned old = xb_add(&bar[XB_XSUB(b.x)], 1u);
        const unsigned gen = old / nloc;
        if (old + 1u == (gen + 1u) * nloc) {
            __builtin_amdgcn_fence(__ATOMIC_RELEASE, "agent");
            asm volatile("s_waitcnt vmcnt(0)" ::: "memory");
            const unsigned og = xb_add(&bar[XB_TOP], 1u);
            const unsigned tg = og / nx;
            if (og + 1u == (tg + 1u) * nx) xb_add(&bar[XB_TOPGEN], 1u);
            else XB_SPIN(xb_ld(&bar[XB_TOPGEN]) == tg, bar);
            __builtin_amdgcn_fence(__ATOMIC_ACQUIRE, "agent");
            xb_add(&bar[XB_XGEN(b.x)], 1u);
            asm volatile("s_waitcnt vmcnt(0)" ::: "memory");
        } else {
            XB_SPIN(xb_ld(&bar[XB_XGEN(b.x)]) == gen, bar);
            __builtin_amdgcn_fence(__ATOMIC_ACQUIRE, "agent");
            asm volatile("s_waitcnt vmcnt(0)" ::: "memory");
        }
    }
    __syncthreads();
}

namespace att {
typedef _Float16 f16x8 __attribute__((ext_vector_type(8)));
typedef short s16x4 __attribute__((ext_vector_type(4)));
typedef short s16x8 __attribute__((ext_vector_type(8)));
typedef float f32x16 __attribute__((ext_vector_type(16)));
typedef unsigned u32x4 __attribute__((ext_vector_type(4)));
typedef __attribute__((address_space(3))) unsigned char* lds_ptr;
typedef __attribute__((address_space(3))) const unsigned char* lds_cptr;
constexpr int NW = 8, QBLK = 32, QB = 256, KVBLK = 64, NSLOT = 3;
constexpr int KSLOTB = 12288, VSLOTB = 8192;
constexpr int LDS_K = 0, LDS_V = NSLOT * KSLOTB, LDS_WS = LDS_V + NSLOT * VSLOTB, LDS_OST = LDS_WS + NW * 256, LDS_KM = LDS_OST + NW * 4096, LDS_BYTES = LDS_KM + 16 * 64 * 4;
__device__ __forceinline__ int crow(int r, int hi) { return (r & 3) + 8 * (r >> 2) + 4 * hi; }
__device__ __forceinline__ void glds16(const void* gsrc, unsigned lds_dst) { unsigned keep;
    asm volatile("s_mov_b32 %0, m0\n\ts_mov_b32 m0, %2\n\ts_nop 0\n\tglobal_load_lds_dwordx4 %1, off\n\ts_mov_b32 m0, %0" : "=&s"(keep) : "v"(gsrc), "s"(lds_dst) : "memory"); }
__device__ __forceinline__ f32x16 mma32(s16x8 a, s16x8 b, f32x16 c) { return __builtin_amdgcn_mfma_f32_32x32x16_f16(__builtin_bit_cast(f16x8, a), __builtin_bit_cast(f16x8, b), c, 0, 0, 0); }
typedef short v4i16_t __attribute__((ext_vector_type(4)));
__device__ __forceinline__ s16x4 vtr(lds_cptr p) { return __builtin_bit_cast(s16x4, __builtin_amdgcn_ds_read_tr16_b64_v4i16((__attribute__((address_space(3))) v4i16_t*)p)); }
__device__ __forceinline__ float rowmax32(const f32x16& p0, const f32x16& p1) {
    float a = fmaxf(p0[0], p1[0]);
#pragma unroll
    for (int r = 1; r < 16; ++r) a = fmaxf(a, fmaxf(p0[r], p1[r]));
    return fmaxf(a, __shfl_xor(a, 32));
}

struct Tensors { const h16 *QN, *QR, *KN, *KR, *VA, *QM, *KM, *VM; const float* kmean; h16* MIX; };

template <int KD, bool MOBA>
__device__ __forceinline__ void attn_unit(int b, int h, int qb, const Tensors& T, lds_ptr shm) {
    int tid_ = threadIdx.x; asm volatile("" : "+v"(tid_));
    const int tid = tid_, lane = tid & 63, r32 = lane & 31, hi = lane >> 5; const int wid = __builtin_amdgcn_readfirstlane(tid >> 6);
    const size_t rowbase = (size_t)b * SEQ; const int q0 = qb * QB;
    const unsigned lds0 = (unsigned)(uintptr_t)shm;
    const h16* Kh = (MOBA ? T.KM : T.KN) + rowbase * 512 + h * 64;
    const h16* Vh = (MOBA ? T.VM : T.VA) + rowbase * 512 + h * 64;
    const h16* KRb = T.KR + rowbase * 32;
    const h16* ksrc = Kh + (size_t)lane * 512 + wid * 8;
    const h16* ksrc2 = KRb + (size_t)lane * 32 + (wid & 3) * 8;
    const h16* vsrc = Vh + (size_t)(16 * (wid & 3) + (lane >> 2)) * 512 + (wid >> 2) * 32 + (lane & 3) * 8;
    const unsigned kdst = lds0 + LDS_K + wid * 1024, kdst2 = lds0 + LDS_K + (8 + (wid & 3)) * 1024, vdst = lds0 + LDS_V + wid * 1024;
    const bool extra = (KD == 6) && (wid < 4);
#define ATT_DMA(t, s) do { glds16(ksrc + (size_t)(t) * KVBLK * 512, (unsigned)__builtin_amdgcn_readfirstlane(kdst + (s) * KSLOTB)); \
        if (extra) glds16(ksrc2 + (size_t)(t) * KVBLK * 32, (unsigned)__builtin_amdgcn_readfirstlane(kdst2 + (s) * KSLOTB)); \
        glds16(vsrc + (size_t)(t) * KVBLK * 512, (unsigned)__builtin_amdgcn_readfirstlane(vdst + (s) * VSLOTB)); } while (0)
    const int NT = (q0 + QB) / KVBLK;
    asm volatile("s_waitcnt vmcnt(0)" ::: "memory");
    __builtin_amdgcn_s_barrier();
    if (MOBA) { for (int e = tid; e < 16 * 64; e += NW * 64) { const int n = e >> 6, d = e & 63; const size_t idx = ((size_t)b * 16 + n) * 512 + h * 64 + d;
            ((__attribute__((address_space(3))) float*)(shm + LDS_KM))[e] = T.kmean[idx] + T.kmean[(size_t)NB * 16 * 512 + idx]; } }
    const size_t qrow = rowbase + q0 + wid * QBLK + r32;
    s16x8 qr[KD];
    if (MOBA) {
#pragma unroll
        for (int d0 = 0; d0 < 4; ++d0) qr[d0] = *(const s16x8*)(T.QM + qrow * 512 + h * 64 + d0 * 16 + hi * 8);
    } else {
#pragma unroll
        for (int d0 = 0; d0 < 4; ++d0) qr[d0] = *(const s16x8*)(T.QN + qrow * 512 + h * 64 + d0 * 16 + hi * 8);
#pragma unroll
        for (int d0 = 4; d0 < KD; ++d0) qr[d0] = *(const s16x8*)(T.QR + qrow * 256 + h * 32 + (d0 - 4) * 16 + hi * 8);
    }
    asm volatile("s_waitcnt vmcnt(0)" ::: "memory");
    ATT_DMA(0, 0); if (NT > 1) ATT_DMA(1, 1);
    __attribute__((address_space(3))) float* wsf = (__attribute__((address_space(3))) float*)(shm + LDS_WS) + wid * 64;
    const int qrel = wid * QBLK + r32;
    unsigned sel = 0u;
    float mref = -INFINITY, l_reg = 0.f; f32x16 o[2]; o[0] = f32x16{}; o[1] = f32x16{};
    const int vboff = ((lane >> 4) & 1) * 32 + (lane & 3) * 8 + (4 * hi + ((lane & 15) >> 2)) * 64;
    int slot = 0;
    for (int t = 0; t < NT; ++t) {
        if (t + 1 < NT) { if (extra) asm volatile("s_waitcnt vmcnt(3)" ::: "memory"); else asm volatile("s_waitcnt vmcnt(2)" ::: "memory"); }
        else asm volatile("s_waitcnt vmcnt(0)" ::: "memory");
        asm volatile("s_waitcnt lgkmcnt(0)\n\ts_barrier" ::: "memory");
        if (t + 2 < NT) { const int s2 = slot == 0 ? 2 : slot - 1; ATT_DMA(t + 2, s2); }
        if (MOBA && t == 0 && qb > 0) {
            const __attribute__((address_space(3))) float* km = (const __attribute__((address_space(3))) float*)(shm + LDS_KM);
            float g[8];
#pragma unroll
            for (int i = 0; i < 8; ++i) g[i] = 0.f;
#pragma unroll
            for (int c = 0; c < 8; ++c) { const s16x8 qv = *(const s16x8*)(T.QM + qrow * 512 + h * 64 + c * 8); const f16x8 qh = __builtin_bit_cast(f16x8, qv);
#pragma unroll
                for (int i = 0; i < 8; ++i) { const int n = 2 * i + hi;
#pragma unroll
                    for (int e = 0; e < 8; ++e) g[i] += (float)qh[e] * km[n * 64 + c * 8 + e]; } }
            float ga[16];
#pragma unroll
            for (int i = 0; i < 8; ++i) { const float other = __shfl_xor(g[i], 32); ga[2 * i] = hi ? other : g[i]; ga[2 * i + 1] = hi ? g[i] : other; }
#pragma unroll
            for (int k = 0; k < 3; ++k) { float best = -INFINITY; int bi = -1;
#pragma unroll
                for (int n = 0; n < 16; ++n) if (n < qb && !((sel >> n) & 1u) && ga[n] > best) { best = ga[n]; bi = n; }
                if (bi >= 0) sel |= 1u << bi; }
        }
        const int jb = t - (NT - 4);
        const bool own = jb >= 0;
        const bool dead = own && (64 * jb > wid * QBLK + 31);
        if (!dead) {
            const lds_cptr kp = (lds_cptr)shm + LDS_K + slot * KSLOTB + hi * 1024 + r32 * 16;
            f32x16 p0 = f32x16{}, p1 = f32x16{};
#pragma unroll
            for (int d0 = 0; d0 < KD; ++d0) {
                const s16x8 k0 = *(const __attribute__((address_space(3))) s16x8*)(kp + d0 * 2048);
                const s16x8 k1 = *(const __attribute__((address_space(3))) s16x8*)(kp + d0 * 2048 + 512);
                p0 = mma32(k0, qr[d0], p0); p1 = mma32(k1, qr[d0], p1);
            }
            if (MOBA && !own) { if (!((sel >> (t >> 2)) & 1u)) {
#pragma unroll
                for (int r = 0; r < 16; ++r) { p0[r] = -INFINITY; p1[r] = -INFINITY; } } }
            if (own && (64 * jb + 63 > wid * QBLK)) {
                const int kb = 64 * jb + 4 * hi;
#pragma unroll
                for (int r = 0; r < 16; ++r) { const int kv = kb + (r & 3) + 8 * (r >> 2); if (kv > qrel) p0[r] = -INFINITY; if (kv + 32 > qrel) p1[r] = -INFINITY; }
            }
            const float rm = rowmax32(p0, p1);
            const float mnew = fmaxf(mref, rm), msub = (mnew == -INFINITY) ? 0.f : mnew;
            const float alpha = exp2f(mref - msub);
            mref = mnew;
            float rs = 0.f;
#pragma unroll
            for (int r = 0; r < 16; ++r) { p0[r] = exp2f(p0[r] - msub); p1[r] = exp2f(p1[r] - msub); rs += p0[r] + p1[r]; }
            l_reg = l_reg * alpha + rs;
            if (__any(alpha != 1.0f)) {
                if (hi == 0) wsf[r32] = alpha;
                asm volatile("s_waitcnt lgkmcnt(0)" ::: "memory");
#pragma unroll
                for (int r = 0; r < 16; ++r) { const float f = wsf[crow(r, hi)]; o[0][r] *= f; o[1][r] *= f; }
                asm volatile("s_waitcnt lgkmcnt(0)" ::: "memory");
            }
            u32x4 pw[4];
#pragma unroll
            for (int i = 0; i < 4; ++i) { pw[0][i] = pk_h16(p0[2 * i], p0[2 * i + 1]); pw[1][i] = pk_h16(p0[8 + 2 * i], p0[9 + 2 * i]); pw[2][i] = pk_h16(p1[2 * i], p1[2 * i + 1]); pw[3][i] = pk_h16(p1[8 + 2 * i], p1[9 + 2 * i]); }
            const lds_cptr vp = (lds_cptr)shm + LDS_V + slot * VSLOTB + vboff;
#pragma unroll
            for (int d0 = 0; d0 < 2; ++d0)
#pragma unroll
                for (int ks = 0; ks < 4; ++ks) { const s16x4 lo = vtr(vp + d0 * 4096 + ks * 1024), hh = vtr(vp + d0 * 4096 + ks * 1024 + 512);
                    const s16x8 vf = {lo[0], lo[1], lo[2], lo[3], hh[0], hh[1], hh[2], hh[3]};
                    o[d0] = mma32(__builtin_bit_cast(s16x8, pw[ks]), vf, o[d0]); }
        }
        slot = slot == 2 ? 0 : slot + 1;
    }
    l_reg += __shfl_xor(l_reg, 32);
    if (hi == 0) wsf[32 + r32] = l_reg;
    asm volatile("s_waitcnt lgkmcnt(0)" ::: "memory");
    h16* Ow = T.MIX + (rowbase + q0 + wid * QBLK) * 1024 + (MOBA ? 512 : 0) + h * 64;
    { __attribute__((address_space(3))) h16* stg = (__attribute__((address_space(3))) h16*)(shm + LDS_OST) + wid * 2048;
#pragma unroll
        for (int r = 0; r < 16; ++r) { const int orow = crow(r, hi); const float rl = 1.0f / wsf[32 + orow];
#pragma unroll
            for (int d0 = 0; d0 < 2; ++d0) stg[orow * 64 + d0 * 32 + r32] = (h16)(o[d0][r] * rl); }
        asm volatile("s_waitcnt lgkmcnt(0)" ::: "memory");
#pragma unroll
        for (int i = 0; i < 4; ++i) { const int row = i * 8 + (lane >> 3), ch = lane & 7; const u32x4 v = *(const __attribute__((address_space(3))) u32x4*)(stg + row * 64 + ch * 8); *(u32x4*)(Ow + (size_t)row * 1024 + ch * 8) = v; } }
    asm volatile("s_waitcnt lgkmcnt(0)\n\ts_barrier" ::: "memory");
#undef ATT_DMA
}
__device__ __forceinline__ void attn_phase(int vcu, const Tensors& T, lds_ptr shm) {
    const int bh = vcu >> 2, sub = vcu & 3, b = bh >> 3, h = bh & 7;
    for (int i = 0; i < 4; ++i) { const int s = 2 * sub + (i >> 1), qb = (i & 1) ? 15 - s : s; attn_unit<6, false>(b, h, qb, T, shm); }
    for (int i = 0; i < 4; ++i) { const int s = 2 * sub + (i >> 1), qb = (i & 1) ? 15 - s : s; attn_unit<4, true>(b, h, qb, T, shm); }
}
}


constexpr int NWAVES = 8;
constexpr int RING_OFF = 0, RING_BYTES = 131072;
constexpr int LDSCTL_OFF = RING_BYTES, MISC_OFF = LDSCTL_OFF + 320;
constexpr int LDS_BYTES = 147456;
#ifndef MK_N_LAUNCHES
#define MK_N_LAUNCHES 1
#endif

struct Frame {
    LAS unsigned char* lds;
    volatile LAS unsigned* MISC;
    gu32* ctl;
    int tid, lane, wave;
    int vcu, G;
};
struct Args {
    const float* in[13]; float* out; unsigned char* ws; int ph_lo, ph_hi;
};

template <int MODE  , bool F16>
__device__ __forceinline__ void p0_transpose_item(const float* W, int K, int N, const float* gk, u16* WT, LAS float* scr, int item, int NP, int lane) {
    const int nblk = NP / 32, kb = item / nblk, nb = item % nblk, k0 = 64 * kb, n0 = 32 * nb;
    const int p = n0 + (lane & 31);
    const int src = MODE == 0 ? src_col_in(p) : MODE == 1 ? src_col_qu(p) : MODE == 2 ? src_col_kvu(p) : p;
#pragma unroll 8
    for (int i = 0; i < 32; ++i) { const int kk = 2 * i + (lane >> 5); float v = src >= 0 ? W[(size_t)(k0 + kk) * N + src] : 0.f; if (gk) v *= gk[k0 + kk]; scr[kk * 33 + (lane & 31)] = v; }
    LDS_WAIT(); asm volatile("" ::: "memory");
    const int c = lane & 7;
#pragma unroll
    for (int j = 0; j < 4; ++j) { const int n = (lane >> 3) + 8 * j; const LAS float* s = scr + (8 * c) * 33 + n;
        v4u o;
        if (F16) { o.x = pk_h16(s[0 * 33], s[1 * 33]); o.y = pk_h16(s[2 * 33], s[3 * 33]); o.z = pk_h16(s[4 * 33], s[5 * 33]); o.w = pk_h16(s[6 * 33], s[7 * 33]); }
        else { o.x = f2bf(s[0 * 33]) | (f2bf(s[1 * 33]) << 16); o.y = f2bf(s[2 * 33]) | (f2bf(s[3 * 33]) << 16); o.z = f2bf(s[4 * 33]) | (f2bf(s[5 * 33]) << 16); o.w = f2bf(s[6 * 33]) | (f2bf(s[7 * 33]) << 16); }
        *(GAS v4u*)(WT + (size_t)(n0 + n) * K + k0 + 8 * c) = o; }
    LDS_WAIT(); asm volatile("" ::: "memory");
}
__device__ __forceinline__ void rms_row_to_h16(int lane, const float* xrow, const float* g, h16* orow) {
    const GAS f32x4* xr = (const GAS f32x4*)xrow + lane;
    f32x4 v[4]; float s = 0.f;
#pragma unroll
    for (int j = 0; j < 4; ++j) { v[j] = xr[64 * j]; s += (v[j].x * v[j].x + v[j].y * v[j].y) + (v[j].z * v[j].z + v[j].w * v[j].w); }
    const float rstd = 1.f / sqrtf(wave_sum(s) * (1.f / DM) + EPS);
    GAS unsigned long long* o8 = (GAS unsigned long long*)orow + lane;
#pragma unroll
    for (int j = 0; j < 4; ++j) { const f32x4 gg = ((const GAS f32x4*)g)[lane + 64 * j];
        o8[64 * j] = (unsigned long long)pk_h16(v[j].x * rstd * gg.x, v[j].y * rstd * gg.y) | ((unsigned long long)pk_h16(v[j].z * rstd * gg.z, v[j].w * rstd * gg.w) << 32); }
}
__device__ __forceinline__ void post4_row(int lane, const float* trow, const float* xrow, const float* g1, const float* g2, float* hrow, u16* xrow2) {
    f32x4 v[4], h[4]; float s = 0.f;
#pragma unroll
    for (int j = 0; j < 4; ++j) { v[j] = ((const GAS f32x4*)trow)[lane + 64 * j]; s += (v[j].x * v[j].x + v[j].y * v[j].y) + (v[j].z * v[j].z + v[j].w * v[j].w); }
    const float rstd = 1.f / sqrtf(wave_sum(s) * (1.f / DM) + EPS); float s2 = 0.f;
#pragma unroll
    for (int j = 0; j < 4; ++j) { const f32x4 xx = ((const GAS f32x4*)xrow)[lane + 64 * j], ga = ((const GAS f32x4*)g1)[lane + 64 * j];
        h[j] = xx + v[j] * rstd * ga; ((GAS f32x4*)hrow)[lane + 64 * j] = h[j]; s2 += (h[j].x * h[j].x + h[j].y * h[j].y) + (h[j].z * h[j].z + h[j].w * h[j].w); }
    const float r2 = 1.f / sqrtf(wave_sum(s2) * (1.f / DM) + EPS);
    GAS unsigned long long* o8 = (GAS unsigned long long*)xrow2 + lane;
#pragma unroll
    for (int j = 0; j < 4; ++j) { const f32x4 gb = ((const GAS f32x4*)g2)[lane + 64 * j];
        o8[64 * j] = (unsigned long long)(f2bf(h[j].x * r2 * gb.x) | (f2bf(h[j].y * r2 * gb.y) << 16)) | ((unsigned long long)(f2bf(h[j].z * r2 * gb.z) | (f2bf(h[j].w * r2 * gb.w) << 16)) << 32); }
}
__device__ __forceinline__ void post6_row(int lane, const float* trow, const float* g, float* orow) {
    f32x4 v[4]; float s = 0.f;
#pragma unroll
    for (int j = 0; j < 4; ++j) { v[j] = ((const GAS f32x4*)trow)[lane + 64 * j]; s += (v[j].x * v[j].x + v[j].y * v[j].y) + (v[j].z * v[j].z + v[j].w * v[j].w); }
    const float rstd = 1.f / sqrtf(wave_sum(s) * (1.f / DM) + EPS);
#pragma unroll
    for (int j = 0; j < 4; ++j) { const f32x4 gg = ((const GAS f32x4*)g)[lane + 64 * j]; GAS f32x4* o = (GAS f32x4*)orow + lane + 64 * j; *o = *o + v[j] * rstd * gg; }
}

constexpr int N_PHASES = 9;
__global__ void __launch_bounds__(NWAVES * 64, 2) mk_fwd(Args args) {
    extern __shared__ __attribute__((aligned(16))) unsigned char lds[];
    Frame F;
    F.lds = (LAS unsigned char*)lds;
    F.MISC = (volatile LAS unsigned*)(F.lds + MISC_OFF);
    F.tid = threadIdx.x; F.lane = F.tid & 63; F.wave = __builtin_amdgcn_readfirstlane(F.tid >> 6);
    F.G = gridDim.x; { const int bx = blockIdx.x; F.vcu = (F.G % 8 == 0) ? (bx % 8) * (F.G / 8) + bx / 8 : bx; }
    unsigned char* ws = args.ws;
    F.ctl = (gu32*)(ws + WS_CTL);
    const float* x = args.in[0]; const float* g_pre = args.in[1]; const float* w_in = args.in[2];
    const float* g_q = args.in[3]; const float* w_qup = args.in[4]; const float* g_kv = args.in[5]; const float* w_kvup = args.in[6];
    const float* w_out = args.in[7]; const float* g_post = args.in[8]; const float* g_pre2 = args.in[9];
    const float* w_up = args.in[10]; const float* w_down = args.in[11]; const float* g_post2 = args.in[12];
    float* out = args.out;
    u16* WIN = (u16*)(ws + WS_WIN); u16* WQU = (u16*)(ws + WS_WQU); u16* WKVU = (u16*)(ws + WS_WKVU); u16* WOUT = (u16*)(ws + WS_WOUT); u16* WUP = (u16*)(ws + WS_WUP); u16* WDN = (u16*)(ws + WS_WDN);
    float2* ropem = (float2*)(ws + WS_ROPE_M); float2* ropea = (float2*)(ws + WS_ROPE_A);
    float* kmean = (float*)(ws + WS_KMEAN); float* rsq_q = (float*)(ws + WS_RSQ); float* rsq_kv = rsq_q + (size_t)M * 4;
    h16* XN = (h16*)(ws + WS_XN); h16* QM = (h16*)(ws + WS_QM); h16* KM = (h16*)(ws + WS_KM); h16* VM = (h16*)(ws + WS_VM);
    h16* CQ = (h16*)(ws + WS_CQ); h16* CKV = (h16*)(ws + WS_CKV); h16* KR = (h16*)(ws + WS_KR);
    h16* QN = (h16*)(ws + WS_QN); h16* QR = (h16*)(ws + WS_QR); h16* KN = (h16*)(ws + WS_KN); h16* VA = (h16*)(ws + WS_VA); h16* MIX = (h16*)(ws + WS_MIX);
    u16* A2 = (u16*)(ws + WS_A2); float* t_out = (float*)(ws + WS_T_OUT); float* t_dn = (float*)(ws + WS_T_DN);

    for (int u = F.tid; u < (LDS_BYTES - LDSCTL_OFF) / 4; u += NWAVES * 64) ((LAS unsigned*)(F.lds + LDSCTL_OFF))[u] = 0u;
    __syncthreads();
    XcdBarrier bar; bar.bar = (unsigned*)(F.ctl + CW_BAR); bar.x = 0; bar.st = nullptr;
    if (MK_N_LAUNCHES == 1) bar = xcd_barrier_post((unsigned*)(F.ctl + CW_BAR), F.MISC + 8);
#define GRID_BAR() do { if (MK_N_LAUNCHES == 1) xcd_barrier(bar); } while (0)
    const int lo = args.ph_lo, hi = args.ph_hi;
#define IN(k) (lo <= (k) && (k) < hi)
#define BOTH(k) (IN(k) && IN((k) + 1))
    int gw, NGW = F.G * NWAVES;
#define FRESH() do { int t_ = threadIdx.x; asm volatile("" : "+v"(t_)); F.tid = t_; F.lane = t_ & 63; F.wave = __builtin_amdgcn_readfirstlane(t_ >> 6); gw = F.vcu * NWAVES + F.wave; } while (0)

    if (IN(0)) { FRESH();
        LAS float* scr = (LAS float*)(F.lds + RING_OFF + F.wave * 16384);
        constexpr int I_IN = (DM / 64) * (NINP / 32), I_QU = (256 / 64) * (768 / 32), I_KVU = (128 / 64) * (1024 / 32), I_OUT = (DM / 64) * (DM / 32), I_UP = (DM / 64) * (FF / 32), I_DN = (FF / 64) * (DM / 32);
        constexpr int NITEMS = I_IN + I_QU + I_KVU + I_OUT + I_UP + I_DN;
        for (int it = gw; it < NITEMS; it += NGW) {
            int r = it;
            if (r < I_IN) { p0_transpose_item<0, true>(w_in, DM, NIN, nullptr, WIN, scr, r, NINP, F.lane); continue; } r -= I_IN;
            if (r < I_QU) { p0_transpose_item<1, true>(w_qup, 256, 768, g_q, WQU, scr, r, 768, F.lane); continue; } r -= I_QU;
            if (r < I_KVU) { p0_transpose_item<2, true>(w_kvup, 128, 1024, g_kv, WKVU, scr, r, 1024, F.lane); continue; } r -= I_KVU;
            if (r < I_OUT) { p0_transpose_item<3, true>(w_out, DM, DM, nullptr, WOUT, scr, r, DM, F.lane); continue; } r -= I_OUT;
            if (r < I_UP) { p0_transpose_item<3, false>(w_up, DM, FF, nullptr, WUP, scr, r, FF, F.lane); continue; } r -= I_UP;
            p0_transpose_item<3, false>(w_down, FF, DM, nullptr, WDN, scr, r, DM, F.lane);
        }
        for (int i = blockIdx.x * (NWAVES * 64) + F.tid; i < SEQ * 32; i += F.G * NWAVES * 64) {
            { const int pos = i / 32, f = i % 32; const float inv = 1.0f / powf(10000.0f, (float)f / 32.0f); const float ang = (float)pos * inv; ropem[i] = make_float2((float)cos((double)ang), (float)sin((double)ang)); }
            if (i < SEQ * 16) { const int pos = i / 16, f = i % 16; const float inv = 1.0f / powf(10000.0f, (float)f / 16.0f); const float ang = (float)pos * inv; ropea[i] = make_float2((float)cos((double)ang), (float)sin((double)ang)); }
        }
        for (int m = gw; m < M; m += NGW) rms_row_to_h16(F.lane, x + (size_t)m * DM, g_pre, XN + (size_t)m * DM);
        if (BOTH(0)) GRID_BAR();
    }
    if (IN(1)) {
        pg8::Gemm g{(const u16*)XN, WIN, M, NINP, DM}; pg8::StaticOrder S; S.init(M, NINP, F.G, (int)blockIdx.x);
        pg8::EpiP1 E{QM, KM, VM, CQ, CKV, KR, kmean, rsq_q, rsq_kv, ropem, ropea};
        pg8::gemm_phase<true, pg8::EpiP1, pg8::StaticOrder, true, true>(F.lds + RING_OFF, g, S, E);
        if (BOTH(1)) GRID_BAR();
    }
    if (IN(2)) {
        { pg8::Gemm g{(const u16*)CQ, WQU, M, 768, 256}; pg8::StaticOrder S; S.init(M, 768, F.G, (int)blockIdx.x);
          pg8::EpiQU E{QN, QR, rsq_q, ropea};
          pg8::gemm_phase<true, pg8::EpiQU, pg8::StaticOrder, true, true>(F.lds + RING_OFF, g, S, E); }
        { pg8::Gemm g{(const u16*)CKV, WKVU, M, 1024, 128}; pg8::StaticOrder S; S.init(M, 1024, F.G, (int)blockIdx.x);
          pg8::EpiKVU E{KN, VA, rsq_kv};
          pg8::gemm_phase<true, pg8::EpiKVU, pg8::StaticOrder, true, true>(F.lds + RING_OFF, g, S, E); }
        if (BOTH(2)) GRID_BAR();
    }
    if (IN(3)) {
        if (F.G == 256) { const att::Tensors T{QN, QR, KN, KR, VA, QM, KM, VM, kmean, MIX}; att::attn_phase(F.vcu, T, F.lds + RING_OFF); }
        if (BOTH(3)) GRID_BAR();
    }
    if (IN(4)) {
        pg8::Gemm g{(const u16*)MIX, WOUT, M, DM, DM}; pg8::StaticOrder S; S.init(M, DM, F.G, (int)blockIdx.x);
        pg8::EpiF32 E{t_out, DM};
        pg8::gemm_phase<true, pg8::EpiF32, pg8::StaticOrder, true, true>(F.lds + RING_OFF, g, S, E);
        if (BOTH(4)) GRID_BAR();
    }
    if (IN(5)) { FRESH();
        for (int m = gw; m < M; m += NGW) post4_row(F.lane, t_out + (size_t)m * DM, x + (size_t)m * DM, g_post, g_pre2, out + (size_t)m * DM, (u16*)XN + (size_t)m * DM);
        if (BOTH(5)) GRID_BAR();
    }
    if (IN(6)) {
        pg8::Gemm g{(const u16*)XN, WUP, M, FF, DM}; pg8::StaticOrder S; S.init(M, FF, F.G, (int)blockIdx.x);
        pg8::EpiRelu2 E{A2, FF};
        pg8::gemm_phase<false, pg8::EpiRelu2, pg8::StaticOrder, true, true>(F.lds + RING_OFF, g, S, E);
        if (BOTH(6)) GRID_BAR();
    }
    if (IN(7)) {
        pg8::Gemm g{(const u16*)A2, WDN, M, DM, FF}; pg8::StaticOrder S; S.init(M, DM, F.G, (int)blockIdx.x);
        pg8::EpiF32 E{t_dn, DM};
        pg8::gemm_phase<false, pg8::EpiF32, pg8::StaticOrder, true, true>(F.lds + RING_OFF, g, S, E);
        if (BOTH(7)) GRID_BAR();
    }
    if (IN(8)) { FRESH();
        for (int m = gw; m < M; m += NGW) post6_row(F.lane, t_dn + (size_t)m * DM, g_post2, out + (size_t)m * DM);
    }
#undef IN
#undef BOTH
}

__global__ void k_rope_tables(float2* tm, float2* ta) {
    const int i = blockIdx.x * blockDim.x + threadIdx.x;
    if (i < SEQ * 32) { const int pos = i / 32, f = i % 32; const float inv = 1.0f / powf(10000.0f, (float)f / 32.0f); const float ang = (float)pos * inv;
        tm[i] = make_float2((float)cos((double)ang), (float)sin((double)ang)); }
    if (i < SEQ * 16) { const int pos = i / 16, f = i % 16; const float inv = 1.0f / powf(10000.0f, (float)f / 16.0f); const float ang = (float)pos * inv;
        ta[i] = make_float2((float)cos((double)ang), (float)sin((double)ang)); }
}

__global__ void k_rmsnorm_f16(const float* x, const float* g, h16* xn) {
    const int lane = threadIdx.x & 63, row = blockIdx.x * 4 + (threadIdx.x >> 6);
    const float4* xr = (const float4*)(x + (size_t)row * DM) + lane;
    float4 v[4]; float s = 0.f;
#pragma unroll
    for (int j = 0; j < 4; ++j) { v[j] = xr[64 * j]; s += (v[j].x * v[j].x + v[j].y * v[j].y) + (v[j].z * v[j].z + v[j].w * v[j].w); }
    const float rstd = 1.0f / sqrtf(wave_sum(s) * (1.f / DM) + EPS);
#pragma unroll
    for (int j = 0; j < 4; ++j) { const float4 gg = ((const float4*)g)[lane + 64 * j]; h16* o = xn + (size_t)row * DM + 4 * (lane + 64 * j);
        o[0] = (h16)(v[j].x * rstd * gg.x); o[1] = (h16)(v[j].y * rstd * gg.y); o[2] = (h16)(v[j].z * rstd * gg.z); o[3] = (h16)(v[j].w * rstd * gg.w); }
}

template <int AT, int EPI>
__global__ void __launch_bounds__(256) k_naive_gemm(const u16* A, int lda, const float* W, int K, int N, float* C32, u16* C16, int ldc) {
    __shared__ __attribute__((aligned(16))) float As[16][260];
    const int t = threadIdx.x, col = blockIdx.x * 256 + t, r0 = blockIdx.y * 16;
    float acc[16];
#pragma unroll
    for (int r = 0; r < 16; ++r) acc[r] = 0.f;
    for (int kc = 0; kc < K; kc += 256) {
        __syncthreads();
#pragma unroll
        for (int i = 0; i < 16; ++i) { const u16 a = A[(size_t)(r0 + i) * lda + kc + t]; As[i][t] = AT == 0 ? (float)__builtin_bit_cast(h16, a) : bf2f(a); }
        __syncthreads();
        if (col < N) {
            for (int k = 0; k < 256; k += 4) {
                const float w0 = W[(size_t)(kc + k) * N + col], w1 = W[(size_t)(kc + k + 1) * N + col], w2 = W[(size_t)(kc + k + 2) * N + col], w3 = W[(size_t)(kc + k + 3) * N + col];
#pragma unroll
                for (int r = 0; r < 16; ++r) { const float4 a = *(const float4*)&As[r][k]; acc[r] += (a.x * w0 + a.y * w1) + (a.z * w2 + a.w * w3); }
            }
        }
    }
    if (col < N) {
#pragma unroll
        for (int r = 0; r < 16; ++r) {
            if (EPI == 0) C32[(size_t)(r0 + r) * ldc + col] = acc[r];
            else { const float v = acc[r] > 0.f ? acc[r] : 0.f; C16[(size_t)(r0 + r) * ldc + col] = (u16)f2bf(v * v); }
        }
    }
}

__global__ void __launch_bounds__(256) k_post1(const float* proj, const float2* ropem, const float2* ropea, h16* CQ, h16* CKV, h16* KR, h16* QM, h16* KM, h16* VM, float* rsq_q, float* rsq_kv) {
    __shared__ float p[NIN]; __shared__ float scr[4];
    const int m = blockIdx.x, t = threadIdx.x, pos = m % SEQ;
    for (int c = t; c < NIN; c += 256) p[c] = proj[(size_t)m * NIN + c];
    __syncthreads();
    { const float v = p[C_CQ + t]; CQ[(size_t)m * 256 + t] = (h16)v; const float ss = block_sum256(v * v, scr); if (t < 4) rsq_q[(size_t)m * 4 + t] = t == 0 ? ss : 0.f; }
    { const float v = t < 128 ? p[C_CKV + t] : 0.f; if (t < 128) CKV[(size_t)m * 128 + t] = (h16)v; const float ss = block_sum256(v * v, scr); if (t < 4) rsq_kv[(size_t)m * 4 + t] = t == 0 ? ss : 0.f; }
    if (t < 16) { const float2 cs = ropea[pos * 16 + t]; const float a = p[C_KR + t], b = p[C_KR + t + 16];
        KR[(size_t)m * 32 + t] = (h16)(a * cs.x - b * cs.y); KR[(size_t)m * 32 + t + 16] = (h16)(b * cs.x + a * cs.y); }
    { const int h = t >> 5, i = t & 31; const float2 cs = ropem[pos * 32 + i];
        { const float a = p[C_MQ + h * 64 + i], b = p[C_MQ + h * 64 + i + 32];
          QM[(size_t)m * 512 + h * 64 + i] = (h16)((a * cs.x - b * cs.y) * C2M); QM[(size_t)m * 512 + h * 64 + i + 32] = (h16)((b * cs.x + a * cs.y) * C2M); }
        { const float a = p[C_MK + h * 64 + i], b = p[C_MK + h * 64 + i + 32];
          KM[(size_t)m * 512 + h * 64 + i] = (h16)(a * cs.x - b * cs.y); KM[(size_t)m * 512 + h * 64 + i + 32] = (h16)(b * cs.x + a * cs.y); } }
    VM[(size_t)m * 512 + t] = (h16)p[C_MV + t]; VM[(size_t)m * 512 + 256 + t] = (h16)p[C_MV + 256 + t];
}

__global__ void __launch_bounds__(512) k_kmean(const h16* KM, float* kmean) {
    const int bb = blockIdx.x, c = threadIdx.x; float s = 0.f;
    for (int r = 0; r < 256; ++r) s += (float)KM[((size_t)bb * 256 + r) * 512 + c];
    kmean[(size_t)bb * 512 + c] = s * (1.f / 256.f); kmean[(size_t)NB * 16 * 512 + (size_t)bb * 512 + c] = 0.f;
}

__global__ void __launch_bounds__(256) k_mla_up(const h16* CQ, const h16* CKV, const float* rsq_q, const float* rsq_kv, const float* gq, const float* Wq, const float* gkv, const float* Wkv,
                                                const float2* ropea, h16* QN, h16* QR, h16* KN, h16* VA) {
    __shared__ float cq[4][256], ckv[4][128], qo[4][768], kvo[4][1024]; __shared__ float rq[4], rkv[4];
    const int t = threadIdx.x, m0 = blockIdx.x * 4;
    for (int i = 0; i < 4; ++i) { cq[i][t] = (float)CQ[(size_t)(m0 + i) * 256 + t] * gq[t]; if (t < 128) ckv[i][t] = (float)CKV[(size_t)(m0 + i) * 128 + t] * gkv[t]; }
    if (t < 4) { const float* a = rsq_q + (size_t)(m0 + t) * 4; rq[t] = 1.0f / sqrtf(((a[0] + a[1]) + (a[2] + a[3])) * (1.f / 256.f) + EPS);
                 const float* b = rsq_kv + (size_t)(m0 + t) * 4; rkv[t] = 1.0f / sqrtf(((b[0] + b[1]) + (b[2] + b[3])) * (1.f / 128.f) + EPS); }
    __syncthreads();
    for (int j = 0; j < 3; ++j) { const int c = t + 256 * j; float a0 = 0, a1 = 0, a2 = 0, a3 = 0;
        for (int k = 0; k < 256; ++k) { const float w = Wq[(size_t)k * 768 + c]; a0 += cq[0][k] * w; a1 += cq[1][k] * w; a2 += cq[2][k] * w; a3 += cq[3][k] * w; }
        qo[0][c] = a0 * rq[0]; qo[1][c] = a1 * rq[1]; qo[2][c] = a2 * rq[2]; qo[3][c] = a3 * rq[3]; }
    for (int j = 0; j < 4; ++j) { const int c = t + 256 * j; float a0 = 0, a1 = 0, a2 = 0, a3 = 0;
        for (int k = 0; k < 128; ++k) { const float w = Wkv[(size_t)k * 1024 + c]; a0 += ckv[0][k] * w; a1 += ckv[1][k] * w; a2 += ckv[2][k] * w; a3 += ckv[3][k] * w; }
        kvo[0][c] = a0 * rkv[0]; kvo[1][c] = a1 * rkv[1]; kvo[2][c] = a2 * rkv[2]; kvo[3][c] = a3 * rkv[3]; }
    __syncthreads();
    for (int i = 0; i < 4; ++i) { const int m = m0 + i, pos = m % SEQ;
        for (int c = t; c < 512; c += 256) { const int h = c >> 6, d = c & 63;
            QN[(size_t)m * 512 + c] = (h16)(qo[i][h * 96 + d] * C2A); KN[(size_t)m * 512 + c] = (h16)kvo[i][h * 128 + d]; VA[(size_t)m * 512 + c] = (h16)kvo[i][h * 128 + 64 + d]; }
        if (t < 128) { const int h = t >> 4, f = t & 15; const float2 cs = ropea[pos * 16 + f]; const float a = qo[i][h * 96 + 64 + f], b = qo[i][h * 96 + 64 + f + 16];
            QR[(size_t)m * 256 + h * 32 + f] = (h16)((a * cs.x - b * cs.y) * C2A); QR[(size_t)m * 256 + h * 32 + f + 16] = (h16)((b * cs.x + a * cs.y) * C2A); } }
}

__global__ void __launch_bounds__(256) k_attn_mla(const h16* QN, const h16* QR, const h16* KN, const h16* KRp, const h16* VA, h16* mix) {
    __shared__ __attribute__((aligned(16))) float Ks[32][96]; __shared__ __attribute__((aligned(16))) float Vs[32][64];
    const int qb = blockIdx.x, h = blockIdx.y, b = blockIdx.z, t = threadIdx.x;
    const int qpos = qb * 256 + t; const size_t m = (size_t)b * SEQ + qpos;
    float q[96], o[64];
#pragma unroll
    for (int d = 0; d < 64; ++d) { q[d] = (float)QN[m * 512 + h * 64 + d]; o[d] = 0.f; }
#pragma unroll
    for (int d = 0; d < 32; ++d) q[64 + d] = (float)QR[m * 256 + h * 32 + d];
    float mx = -INFINITY, l = 0.f;
    for (int t0 = 0; t0 < qb * 256 + 256; t0 += 32) {
        __syncthreads();
        for (int e = t; e < 32 * 96; e += 256) { const int j = e / 96, d = e % 96; const size_t km = (size_t)b * SEQ + t0 + j;
            Ks[j][d] = d < 64 ? (float)KN[km * 512 + h * 64 + d] : (float)KRp[km * 32 + d - 64]; }
        for (int e = t; e < 32 * 64; e += 256) { const int j = e >> 6, d = e & 63; Vs[j][d] = (float)VA[((size_t)b * SEQ + t0 + j) * 512 + h * 64 + d]; }
        __syncthreads();
        float s[32]; float mt = -INFINITY;
#pragma unroll
        for (int j = 0; j < 32; ++j) { float a = 0.f;
#pragma unroll
            for (int d = 0; d < 96; d += 4) { const float4 kk = *(const float4*)&Ks[j][d]; a += (q[d] * kk.x + q[d + 1] * kk.y) + (q[d + 2] * kk.z + q[d + 3] * kk.w); }
            s[j] = (t0 + j <= qpos) ? a : -INFINITY; mt = fmaxf(mt, s[j]); }
        const float mn = fmaxf(mx, mt);
        if (mn == -INFINITY) continue;
        const float alpha = exp2f(mx - mn); mx = mn; l *= alpha;
#pragma unroll
        for (int d = 0; d < 64; ++d) o[d] *= alpha;
#pragma unroll
        for (int j = 0; j < 32; ++j) { const float pj = exp2f(s[j] - mn); l += pj;
#pragma unroll
            for (int d = 0; d < 64; d += 4) { const float4 vv = *(const float4*)&Vs[j][d]; o[d] += pj * vv.x; o[d + 1] += pj * vv.y; o[d + 2] += pj * vv.z; o[d + 3] += pj * vv.w; } }
    }
    const float rl = 1.0f / l;
#pragma unroll
    for (int d = 0; d < 64; ++d) mix[m * 1024 + h * 64 + d] = (h16)(o[d] * rl);
}

__global__ void __launch_bounds__(256) k_attn_moba(const h16* QM, const h16* KM, const h16* VM, const float* kmean, h16* mix) {
    __shared__ __attribute__((aligned(16))) float Ks[32][64]; __shared__ __attribute__((aligned(16))) float Vs[32][64]; __shared__ float km[16][64];
    const int cur = blockIdx.x, h = blockIdx.y, b = blockIdx.z, t = threadIdx.x;
    const int qpos = cur * 256 + t; const size_t m = (size_t)b * SEQ + qpos;
    for (int e = t; e < 16 * 64; e += 256) { const int n = e >> 6, d = e & 63; const size_t idx = ((size_t)b * 16 + n) * 512 + h * 64 + d; km[n][d] = kmean[idx] + kmean[(size_t)NB * 16 * 512 + idx]; }
    float q[64], o[64];
#pragma unroll
    for (int d = 0; d < 64; ++d) { q[d] = (float)QM[m * 512 + h * 64 + d]; o[d] = 0.f; }
    __syncthreads();
    unsigned sel = 0u;
    if (cur <= 3) sel = (1u << cur) - 1u;
    else {
        float g[16];
#pragma unroll
        for (int n = 0; n < 16; ++n) { float a = 0.f;
#pragma unroll
            for (int d = 0; d < 64; ++d) a += q[d] * km[n][d];
            g[n] = n < cur ? a : -INFINITY; }
        for (int k = 0; k < 3; ++k) { float best = -INFINITY; int bi = 0;
#pragma unroll
            for (int n = 0; n < 16; ++n) if (!((sel >> n) & 1u) && g[n] > best) { best = g[n]; bi = n; }
            sel |= 1u << bi; }
    }
    float mx = -INFINITY, l = 0.f;
    for (int t0 = 0; t0 < cur * 256 + 256; t0 += 32) {
        const int n = t0 >> 8;
        __syncthreads();
        for (int e = t; e < 32 * 64; e += 256) { const int j = e >> 6, d = e & 63; const size_t km_ = ((size_t)b * SEQ + t0 + j) * 512 + h * 64 + d; Ks[j][d] = (float)KM[km_]; Vs[j][d] = (float)VM[km_]; }
        __syncthreads();
        const bool blk_ok = (n == cur) || ((sel >> n) & 1u);
        float s[32]; float mt = -INFINITY;
#pragma unroll
        for (int j = 0; j < 32; ++j) { float a = 0.f;
#pragma unroll
            for (int d = 0; d < 64; d += 4) { const float4 kk = *(const float4*)&Ks[j][d]; a += (q[d] * kk.x + q[d + 1] * kk.y) + (q[d + 2] * kk.z + q[d + 3] * kk.w); }
            s[j] = (blk_ok && (t0 + j <= qpos)) ? a : -INFINITY; mt = fmaxf(mt, s[j]); }
        const float mn = fmaxf(mx, mt);
        if (mn == -INFINITY) continue;
        const float alpha = exp2f(mx - mn); mx = mn; l *= alpha;
#pragma unroll
        for (int d = 0; d < 64; ++d) o[d] *= alpha;
#pragma unroll
        for (int j = 0; j < 32; ++j) { const float pj = exp2f(s[j] - mn); l += pj;
#pragma unroll
            for (int d = 0; d < 64; d += 4) { const float4 vv = *(const float4*)&Vs[j][d]; o[d] += pj * vv.x; o[d + 1] += pj * vv.y; o[d + 2] += pj * vv.z; o[d + 3] += pj * vv.w; } }
    }
    const float rl = 1.0f / l;
#pragma unroll
    for (int d = 0; d < 64; ++d) mix[m * 1024 + 512 + h * 64 + d] = (h16)(o[d] * rl);
}

__global__ void __launch_bounds__(256) k_post4(const float* tmp, const float* x, const float* g1, const float* g2, float* hout, u16* xn2) {
    __shared__ float scr[4];
    const int m = blockIdx.x, t = threadIdx.x;
    const float4 v = ((const float4*)(tmp + (size_t)m * DM))[t];
    const float ss = block_sum256((v.x * v.x + v.y * v.y) + (v.z * v.z + v.w * v.w), scr);
    const float rstd = 1.0f / sqrtf(ss * (1.f / DM) + EPS);
    const float4 xx = ((const float4*)(x + (size_t)m * DM))[t], ga = ((const float4*)g1)[t], gb = ((const float4*)g2)[t];
    float4 hh; hh.x = xx.x + v.x * rstd * ga.x; hh.y = xx.y + v.y * rstd * ga.y; hh.z = xx.z + v.z * rstd * ga.z; hh.w = xx.w + v.w * rstd * ga.w;
    ((float4*)(hout + (size_t)m * DM))[t] = hh;
    const float ss2 = block_sum256((hh.x * hh.x + hh.y * hh.y) + (hh.z * hh.z + hh.w * hh.w), scr);
    const float r2 = 1.0f / sqrtf(ss2 * (1.f / DM) + EPS);
    u16* o = xn2 + (size_t)m * DM + 4 * t;
    o[0] = (u16)f2bf(hh.x * r2 * gb.x); o[1] = (u16)f2bf(hh.y * r2 * gb.y); o[2] = (u16)f2bf(hh.z * r2 * gb.z); o[3] = (u16)f2bf(hh.w * r2 * gb.w);
}
__global__ void __launch_bounds__(256) k_post6(const float* tmp, const float* g, float* out) {
    __shared__ float scr[4];
    const int m = blockIdx.x, t = threadIdx.x;
    const float4 v = ((const float4*)(tmp + (size_t)m * DM))[t];
    const float ss = block_sum256((v.x * v.x + v.y * v.y) + (v.z * v.z + v.w * v.w), scr);
    const float rstd = 1.0f / sqrtf(ss * (1.f / DM) + EPS);
    const float4 gg = ((const float4*)g)[t]; float4 hh = ((float4*)(out + (size_t)m * DM))[t];
    hh.x += v.x * rstd * gg.x; hh.y += v.y * rstd * gg.y; hh.z += v.z * rstd * gg.z; hh.w += v.w * rstd * gg.w;
    ((float4*)(out + (size_t)m * DM))[t] = hh;
}


#ifndef HY
#define HY 0x7f
#endif
constexpr size_t WS_T_PROJ = 256 * MiB;
static void launch_mk(Args a, int lo, int hi, int grid, hipStream_t stream) {
    a.ph_lo = lo; a.ph_hi = hi;
    hipLaunchKernelGGL(mk_fwd, dim3(grid), dim3(NWAVES * 64), LDS_BYTES, stream, a);
}
extern "C" void kernel_launch(void* const* d_in, const int* in_sizes, int n_in, void* d_out, int out_size, void* d_ws, size_t ws_size, hipStream_t stream) {
    static int grid = 0;
    if (grid == 0) {
        if (n_in != 13 || in_sizes[0] != M * DM || out_size != M * DM || ws_size < 500 * MiB) { fprintf(stderr, "kernel_launch: unexpected shapes (n_in %d, ws %zu)\n", n_in, ws_size); grid = -1; return; }
        int dev = 0, cus = 0;
        if (hipGetDevice(&dev) != hipSuccess || hipDeviceGetAttribute(&cus, hipDeviceAttributeMultiprocessorCount, dev) != hipSuccess) { grid = -1; return; }
        if (hipFuncSetAttribute((const void*)mk_fwd, hipFuncAttributeMaxDynamicSharedMemorySize, LDS_BYTES) != hipSuccess) { fprintf(stderr, "kernel_launch: hipFuncSetAttribute failed\n"); grid = -1; return; }
        grid = cus;
    }
    if (grid < 0) return;
    const float* x = (const float*)d_in[0]; const float* g_pre = (const float*)d_in[1]; const float* w_in = (const float*)d_in[2];
    const float* g_q = (const float*)d_in[3]; const float* w_qup = (const float*)d_in[4]; const float* g_kv = (const float*)d_in[5]; const float* w_kvup = (const float*)d_in[6];
    const float* w_out = (const float*)d_in[7]; const float* g_post = (const float*)d_in[8]; const float* g_pre2 = (const float*)d_in[9];
    const float* w_up = (const float*)d_in[10]; const float* w_down = (const float*)d_in[11]; const float* g_post2 = (const float*)d_in[12];
    unsigned char* ws = (unsigned char*)d_ws; float* out = (float*)d_out;
    float2* ropem = (float2*)(ws + WS_ROPE_M); float2* ropea = (float2*)(ws + WS_ROPE_A);
    float* kmean = (float*)(ws + WS_KMEAN); float* rsq_q = (float*)(ws + WS_RSQ); float* rsq_kv = rsq_q + (size_t)M * 4;
    h16* XN = (h16*)(ws + WS_XN); h16* QM = (h16*)(ws + WS_QM); h16* KM = (h16*)(ws + WS_KM); h16* VM = (h16*)(ws + WS_VM);
    h16* CQ = (h16*)(ws + WS_CQ); h16* CKV = (h16*)(ws + WS_CKV); h16* KR = (h16*)(ws + WS_KR);
    h16* QN = (h16*)(ws + WS_QN); h16* QR = (h16*)(ws + WS_QR); h16* KN = (h16*)(ws + WS_KN); h16* VA = (h16*)(ws + WS_VA); h16* MIX = (h16*)(ws + WS_MIX);
    u16* A2 = (u16*)(ws + WS_A2);
    float* t_proj = (float*)(ws + WS_T_PROJ); float* t_out = (float*)(ws + WS_T_OUT); float* t_dn = (float*)(ws + WS_T_DN);
    (void)hipMemsetAsync(ws + WS_CTL, 0, CTL_ZERO_BYTES, stream);
    Args a{};
    for (int i = 0; i < 13; ++i) a.in[i] = (const float*)d_in[i];
    a.out = out; a.ws = ws;

#if MK_N_LAUNCHES == 1
    launch_mk(a, 0, N_PHASES, grid, stream);
    return;
#endif
    launch_mk(a, 0, 1, grid, stream);
    if (!(HY & 0x20)) { k_rope_tables<<<SEQ * 32 / 256, 256, 0, stream>>>(ropem, ropea); k_rmsnorm_f16<<<M / 4, 256, 0, stream>>>(x, g_pre, XN); }
    if (HY & 0x01) launch_mk(a, 1, 2, grid, stream);
    else {
        k_naive_gemm<0, 0><<<dim3((NIN + 255) / 256, M / 16), 256, 0, stream>>>((const u16*)XN, DM, w_in, DM, NIN, t_proj, nullptr, NIN);
        k_post1<<<M, 256, 0, stream>>>(t_proj, ropem, ropea, CQ, CKV, KR, QM, KM, VM, rsq_q, rsq_kv);
        k_kmean<<<NB * 16, 512, 0, stream>>>(KM, kmean);
    }
    if (HY & 0x02) launch_mk(a, 2, 3, grid, stream);
    else k_mla_up<<<M / 4, 256, 0, stream>>>(CQ, CKV, rsq_q, rsq_kv, g_q, w_qup, g_kv, w_kvup, ropea, QN, QR, KN, VA);
    if (HY & 0x40) launch_mk(a, 3, 4, grid, stream);
    else {
    k_attn_mla<<<dim3(16, 8, NB), 256, 0, stream>>>(QN, QR, KN, KR, VA, MIX);
    k_attn_moba<<<dim3(16, 8, NB), 256, 0, stream>>>(QM, KM, VM, kmean, MIX);
    }
    if (HY & 0x04) { launch_mk(a, 4, 5, grid, stream); launch_mk(a, 5, 6, grid, stream); }
    else {
        k_naive_gemm<0, 0><<<dim3(DM / 256, M / 16), 256, 0, stream>>>((const u16*)MIX, DM, w_out, DM, DM, t_out, nullptr, DM);
        k_post4<<<M, 256, 0, stream>>>(t_out, x, g_post, g_pre2, out, (u16*)XN);
    }
    if (HY & 0x08) launch_mk(a, 6, 7, grid, stream);
    else k_naive_gemm<1, 1><<<dim3(FF / 256, M / 16), 256, 0, stream>>>((const u16*)XN, DM, w_up, DM, FF, nullptr, A2, FF);
    if (HY & 0x10) { launch_mk(a, 7, 8, grid, stream); launch_mk(a, 8, 9, grid, stream); }
    else {
        k_naive_gemm<1, 0><<<dim3(DM / 256, M / 16), 256, 0, stream>>>(A2, FF, w_down, FF, DM, t_dn, nullptr, DM);
        k_post6<<<M, 256, 0, stream>>>(t_dn, g_post2, out);
    }
}
```

```cpp
#include <hip/hip_runtime.h>
#include <cstdint>
#include <cstdio>
#include <cmath>

constexpr int NB = 8, SEQ = 4096, DM = 1024, M = NB * SEQ;
constexpr int NIN = 1952, NINP = 2048, FF = 4096;
constexpr int C_CQ = 0, C_CKV = 256, C_KR = 384, C_MQ = 416, C_MK = 928, C_MV = 1440;
constexpr float EPS = 1e-6f;
constexpr float LOG2E = 1.4426950408889634f;
constexpr float C2M = 0.125f * LOG2E;
constexpr float C2A = 0.10206207261596577f * LOG2E;

typedef _Float16 h16;
typedef unsigned short u16;

constexpr size_t MiB = 1u << 20;
constexpr size_t WS_CTL = 0, CTL_ZERO_BYTES = 1 * MiB;
constexpr size_t WS_WIN = 2 * MiB;
constexpr size_t WS_WQU = 6 * MiB;
constexpr size_t WS_WKVU = 6 * MiB + 512 * 1024;
constexpr size_t WS_WOUT = 7 * MiB;
constexpr size_t WS_WUP = 9 * MiB;
constexpr size_t WS_WDN = 17 * MiB;
constexpr size_t WS_ROPE_M = 25 * MiB;
constexpr size_t WS_ROPE_A = 26 * MiB;
constexpr size_t WS_KMEAN = 27 * MiB;
constexpr size_t WS_RSQ = 28 * MiB;
constexpr size_t WS_XN = 32 * MiB;
constexpr size_t WS_QM = 96 * MiB, WS_KM = 128 * MiB, WS_VM = 160 * MiB;
constexpr size_t WS_CQ = 192 * MiB;
constexpr size_t WS_CKV = 208 * MiB;
constexpr size_t WS_KR = 216 * MiB;
constexpr size_t WS_QN = 220 * MiB;
constexpr size_t WS_QR = 252 * MiB;
constexpr size_t WS_KN = 268 * MiB;
constexpr size_t WS_VA = 300 * MiB;
constexpr size_t WS_MIX = 332 * MiB;
constexpr size_t WS_A2 = 96 * MiB;
constexpr size_t WS_T_OUT = 96 * MiB;
constexpr size_t WS_T_DN = 352 * MiB;
constexpr size_t WS_NEED = 480 * MiB;
constexpr int CW_BAR = 4096;

__device__ __forceinline__ unsigned f2bf(float f) { unsigned u = __builtin_bit_cast(unsigned, f); return (u + 0x7fffu + ((u >> 16) & 1u)) >> 16; }
__device__ __forceinline__ float bf2f(u16 b) { return __builtin_bit_cast(float, (unsigned)b << 16); }
typedef _Float16 h16x2_t __attribute__((ext_vector_type(2)));
__device__ __forceinline__ unsigned pk_h16(float lo, float hi) { h16x2_t v = {(h16)lo, (h16)hi}; return __builtin_bit_cast(unsigned, v); }
__device__ __forceinline__ unsigned pk_bf16(float lo, float hi) { unsigned r; asm volatile("v_cvt_pk_bf16_f32 %0, %1, %2" : "=v"(r) : "v"(lo), "v"(hi)); return r; }

__device__ __forceinline__ float wave_sum(float v) {
#pragma unroll
    for (int o = 1; o < 64; o <<= 1) v += __shfl_xor(v, o);
    return v;
}
__device__ __forceinline__ float block_sum256(float v, float* scr) {
    v = wave_sum(v);
    __syncthreads();
    if ((threadIdx.x & 63) == 0) scr[threadIdx.x >> 6] = v;
    __syncthreads();
    return (scr[0] + scr[1]) + (scr[2] + scr[3]);
}

__host__ __device__ __forceinline__ int src_col_in(int p) {
    const int tile = p >> 8, q = p & 255, bj = q >> 7, wc = (q >> 5) & 3, fq = (q >> 3) & 3, n = (q >> 2) & 1, j = q & 3;
    if (tile < 4) { const int head = (tile & 1) * 4 + 2 * bj + (wc >> 1), d = 32 * n + 16 * (wc & 1) + 4 * fq + j; return (tile < 2 ? C_MQ : C_MK) + head * 64 + d; }
    if (tile < 6) return C_MV + (tile - 4) * 256 + q;
    if (tile == 6) return C_CQ + q;
    if (q < 128) return C_CKV + q;
    if (q < 160) return C_KR + 16 * n + 4 * fq + j;
    return -1;
}
__host__ __device__ __forceinline__ int src_col_qu(int p) {
    if (p < 512) return (p >> 6) * 96 + (p & 63);
    const int q = p - 512, bj = q >> 7, wc = (q >> 5) & 3, fq = (q >> 3) & 3, n = (q >> 2) & 1, j = q & 3;
    return (4 * bj + wc) * 96 + 64 + 16 * n + 4 * fq + j;
}
__host__ __device__ __forceinline__ int src_col_kvu(int p) { return p < 512 ? (p >> 6) * 128 + (p & 63) : ((p - 512) >> 6) * 128 + 64 + (p & 63); }


namespace pg8 {
#define PG8_LAS __attribute__((address_space(3)))
typedef short bf16x8 __attribute__((ext_vector_type(8)));
typedef _Float16 f16x8 __attribute__((ext_vector_type(8)));
typedef float f32x4 __attribute__((ext_vector_type(4)));
typedef unsigned u32x4 __attribute__((ext_vector_type(4)));
typedef unsigned u32x2 __attribute__((ext_vector_type(2)));
constexpr int BM = 256, BK = 64, HALF = 128, HTB = HALF * BK * 2  , STAGE_BYTES = 8 * HTB, NXCD = 8, WGM = 8;

__host__ __device__ __forceinline__ int lds_byte(int r, int c) { const int st = (r >> 4) * 2 + (c >> 5), rr = r & 15, cc = c & 31, ob = rr * 64 + cc * 2; return st * 1024 + (ob ^ (((ob >> 9) & 1) << 5)); }
__host__ __device__ __forceinline__ void stage_rc(int b, int& R, int& C) { const int st = b / 1024, sb = b % 1024, swz = sb ^ (((sb >> 9) & 1) << 5); R = (st >> 1) * 16 + swz / 64; C = (st & 1) * 32 + (swz % 64) / 2; }
__host__ __device__ __forceinline__ int perm32(int rho) { const int n = rho >> 4, i = rho & 15; return 8 * (i >> 2) + 4 * n + (i & 3); }

struct Unit { int pm, pn; };
struct Gemm { const u16* A; const u16* Bt; int M, N, K; };

struct StaticOrder {
    int nM, nN, nwg, G, c;
    __host__ __device__ void init(int M_, int N_, int G_, int c_) { nM = M_ / BM; nN = N_ / BM; nwg = nM * nN; G = G_; c = c_; }
    __host__ __device__ bool next(int i, Unit& u) const {
        const long L = (long)i * G + c; if (L >= nwg) return false;
        int wgid = (int)L; { const int q = nwg / NXCD, r = nwg % NXCD, xcd = wgid % NXCD, off = wgid / NXCD; wgid = (xcd < r ? xcd * (q + 1) : r * (q + 1) + (xcd - r) * q) + off; }
        const int nig = WGM * nN, gid = wgid / nig, fm = gid * WGM, gsz = (nM - fm) < WGM ? (nM - fm) : WGM;
        u.pm = fm + ((wgid % nig) % gsz); u.pn = (wgid % nig) / gsz; return true;
    }
    __device__ __forceinline__ void a_ready(const Unit&) const {}
    __device__ __forceinline__ void done(const Unit&) const {}
};

__device__ __forceinline__ u32x4 pack8_h16(const f32x4& v0, const f32x4& v1, float s) {
    u32x4 w; w.x = pk_h16(v0[0] * s, v0[1] * s); w.y = pk_h16(v0[2] * s, v0[3] * s); w.z = pk_h16(v1[0] * s, v1[1] * s); w.w = pk_h16(v1[2] * s, v1[3] * s); return w; }

struct EpiP1 {
    static constexpr bool PERM = true, AFTER_DRAIN = false;
    h16 *QM, *KM, *VM, *CQ, *CKV, *KR; float *kmean, *rsq_q, *rsq_kv; const float2 *ropem, *ropea;
    __device__ __forceinline__ void operator()(const f32x4 (&acc)[2][2][4][2], const Unit& u, int wr, int wc, int fr, int fq) const {
        const int pn = u.pn, row0 = u.pm * BM + wr * 64 + fr;
        if (pn < 4) {
            const bool isq = pn < 2; h16* dst = isq ? QM : KM; const float sc = isq ? C2M : 1.f;
            const int hbase = (pn & 1) * 4 + (wc >> 1), dlo = 16 * (wc & 1) + 4 * fq;
            f32x4 ks[2][2];
#pragma unroll
            for (int bj = 0; bj < 2; ++bj) { ks[bj][0] = (f32x4){0.f, 0.f, 0.f, 0.f}; ks[bj][1] = (f32x4){0.f, 0.f, 0.f, 0.f}; }
#pragma unroll
            for (int ai = 0; ai < 2; ++ai)
#pragma unroll
                for (int m = 0; m < 4; ++m) {
                    const int r = row0 + ai * HALF + m * 16, pos = r & (SEQ - 1);
                    const f32x4* tp = (const f32x4*)(ropem + pos * 32 + dlo); const f32x4 t0 = tp[0], t1 = tp[1];
                    const f32x4 cs = {t0[0], t0[2], t1[0], t1[2]}, sn = {t0[1], t0[3], t1[1], t1[3]};
#pragma unroll
                    for (int bj = 0; bj < 2; ++bj) {
                        const f32x4 a = acc[ai][bj][m][0], b = acc[ai][bj][m][1];
                        const f32x4 lo = a * cs - b * sn, hi = b * cs + a * sn;
                        ks[bj][0] += lo; ks[bj][1] += hi;
                        h16* p = dst + (size_t)r * 512 + (hbase + 2 * bj) * 64 + dlo;
                        u32x2 w0, w1; w0.x = pk_h16(lo[0] * sc, lo[1] * sc); w0.y = pk_h16(lo[2] * sc, lo[3] * sc); w1.x = pk_h16(hi[0] * sc, hi[1] * sc); w1.y = pk_h16(hi[2] * sc, hi[3] * sc);
                        *(u32x2*)p = w0; *(u32x2*)(p + 32) = w1;
                    }
                }
            if (!isq) {
#pragma unroll
                for (int bj = 0; bj < 2; ++bj)
#pragma unroll
                    for (int n = 0; n < 2; ++n) {
                        f32x4 s = ks[bj][n];
#pragma unroll
                        for (int o = 1; o < 16; o <<= 1) { s[0] += __shfl_xor(s[0], o); s[1] += __shfl_xor(s[1], o); s[2] += __shfl_xor(s[2], o); s[3] += __shfl_xor(s[3], o); }
                        if (fr == 0) *(f32x4*)(kmean + ((size_t)wr * (NB * 16) + u.pm) * 512 + (hbase + 2 * bj) * 64 + dlo + 32 * n) = s * (1.f / 256.f);
                    }
            }
        } else if (pn < 6) {
#pragma unroll
            for (int ai = 0; ai < 2; ++ai)
#pragma unroll
                for (int m = 0; m < 4; ++m) { h16* p = VM + (size_t)(row0 + ai * HALF + m * 16) * 512 + (pn - 4) * 256 + wc * 32 + 8 * fq;
#pragma unroll
                    for (int bj = 0; bj < 2; ++bj) *(u32x4*)(p + bj * HALF) = pack8_h16(acc[ai][bj][m][0], acc[ai][bj][m][1], 1.f); }
        } else if (pn == 6) {
#pragma unroll
            for (int ai = 0; ai < 2; ++ai)
#pragma unroll
                for (int m = 0; m < 4; ++m) { const int r = row0 + ai * HALF + m * 16; h16* p = CQ + (size_t)r * 256 + wc * 32 + 8 * fq; float ss = 0.f;
#pragma unroll
                    for (int bj = 0; bj < 2; ++bj) { const f32x4 v0 = acc[ai][bj][m][0], v1 = acc[ai][bj][m][1]; *(u32x4*)(p + bj * HALF) = pack8_h16(v0, v1, 1.f);
                        ss += (v0[0] * v0[0] + v0[1] * v0[1]) + (v0[2] * v0[2] + v0[3] * v0[3]) + (v1[0] * v1[0] + v1[1] * v1[1]) + (v1[2] * v1[2] + v1[3] * v1[3]); }
                    ss += __shfl_xor(ss, 16); ss += __shfl_xor(ss, 32);
                    if (fq == 0) rsq_q[(size_t)r * 4 + wc] = ss; }
        } else {
#pragma unroll
            for (int ai = 0; ai < 2; ++ai)
#pragma unroll
                for (int m = 0; m < 4; ++m) { const int r = row0 + ai * HALF + m * 16, pos = r & (SEQ - 1);
                    const f32x4 v0 = acc[ai][0][m][0], v1 = acc[ai][0][m][1]; *(u32x4*)(CKV + (size_t)r * 128 + wc * 32 + 8 * fq) = pack8_h16(v0, v1, 1.f);
                    float ss = (v0[0] * v0[0] + v0[1] * v0[1]) + (v0[2] * v0[2] + v0[3] * v0[3]) + (v1[0] * v1[0] + v1[1] * v1[1]) + (v1[2] * v1[2] + v1[3] * v1[3]);
                    ss += __shfl_xor(ss, 16); ss += __shfl_xor(ss, 32);
                    if (fq == 0) rsq_kv[(size_t)r * 4 + wc] = ss;
                    if (wc == 0) { const f32x4* tp = (const f32x4*)(ropea + pos * 16 + 4 * fq); const f32x4 t0 = tp[0], t1 = tp[1];
                        const f32x4 cs = {t0[0], t0[2], t1[0], t1[2]}, sn = {t0[1], t0[3], t1[1], t1[3]};
                        const f32x4 a = acc[ai][1][m][0], b = acc[ai][1][m][1]; const f32x4 lo = a * cs - b * sn, hi = b * cs + a * sn;
                        h16* p = KR + (size_t)r * 32 + 4 * fq; u32x2 w0, w1; w0.x = pk_h16(lo[0], lo[1]); w0.y = pk_h16(lo[2], lo[3]); w1.x = pk_h16(hi[0], hi[1]); w1.y = pk_h16(hi[2], hi[3]);
                        *(u32x2*)p = w0; *(u32x2*)(p + 16) = w1; } }
        }
    }
};
struct EpiQU {
    static constexpr bool PERM = true, AFTER_DRAIN = false;
    h16 *QN, *QR; const float* rsq_q; const float2* ropea;
    __device__ __forceinline__ void operator()(const f32x4 (&acc)[2][2][4][2], const Unit& u, int wr, int wc, int fr, int fq) const {
        const int pn = u.pn, row0 = u.pm * BM + wr * 64 + fr;
#pragma unroll
        for (int ai = 0; ai < 2; ++ai)
#pragma unroll
            for (int m = 0; m < 4; ++m) { const int r = row0 + ai * HALF + m * 16, pos = r & (SEQ - 1);
                const f32x4 pr = *(const f32x4*)(rsq_q + (size_t)r * 4); const float rq = C2A / sqrtf(((pr[0] + pr[1]) + (pr[2] + pr[3])) * (1.f / 256.f) + EPS);
                if (pn < 2) { h16* p = QN + (size_t)r * 512 + pn * 256 + wc * 32 + 8 * fq;
#pragma unroll
                    for (int bj = 0; bj < 2; ++bj) *(u32x4*)(p + bj * HALF) = pack8_h16(acc[ai][bj][m][0], acc[ai][bj][m][1], rq);
                } else { const f32x4* tp = (const f32x4*)(ropea + pos * 16 + 4 * fq); const f32x4 t0 = tp[0], t1 = tp[1];
                    const f32x4 cs = {t0[0], t0[2], t1[0], t1[2]}, sn = {t0[1], t0[3], t1[1], t1[3]};
#pragma unroll
                    for (int bj = 0; bj < 2; ++bj) { const f32x4 a = acc[ai][bj][m][0], b = acc[ai][bj][m][1]; const f32x4 lo = (a * cs - b * sn) * rq, hi = (b * cs + a * sn) * rq;
                        h16* p = QR + (size_t)r * 256 + (4 * bj + wc) * 32 + 4 * fq; u32x2 w0, w1; w0.x = pk_h16(lo[0], lo[1]); w0.y = pk_h16(lo[2], lo[3]); w1.x = pk_h16(hi[0], hi[1]); w1.y = pk_h16(hi[2], hi[3]);
                        *(u32x2*)p = w0; *(u32x2*)(p + 16) = w1; } } }
    }
};
struct EpiKVU {
    static constexpr bool PERM = true, AFTER_DRAIN = false;
    h16 *KN, *VA; const float* rsq_kv;
    __device__ __forceinline__ void operator()(const f32x4 (&acc)[2][2][4][2], const Unit& u, int wr, int wc, int fr, int fq) const {
        const int pn = u.pn, row0 = u.pm * BM + wr * 64 + fr; h16* dst = (pn < 2 ? KN : VA) + (pn & 1) * 256 + wc * 32 + 8 * fq;
#pragma unroll
        for (int ai = 0; ai < 2; ++ai)
#pragma unroll
            for (int m = 0; m < 4; ++m) { const int r = row0 + ai * HALF + m * 16;
                const f32x4 pr = *(const f32x4*)(rsq_kv + (size_t)r * 4); const float rk = 1.0f / sqrtf(((pr[0] + pr[1]) + (pr[2] + pr[3])) * (1.f / 128.f) + EPS);
                h16* p = dst + (size_t)r * 512;
#pragma unroll
                for (int bj = 0; bj < 2; ++bj) *(u32x4*)(p + bj * HALF) = pack8_h16(acc[ai][bj][m][0], acc[ai][bj][m][1], rk); }
    }
};
struct EpiF32 {
    static constexpr bool PERM = false, AFTER_DRAIN = false;
    float* C; int ldc;
    __device__ __forceinline__ void operator()(const f32x4 (&acc)[2][2][4][2], const Unit& u, int wr, int wc, int fr, int fq) const {
        const int row0 = u.pm * BM + wr * 64 + fr, col0 = u.pn * BM + wc * 32 + 4 * fq;
#pragma unroll
        for (int ai = 0; ai < 2; ++ai)
#pragma unroll
            for (int m = 0; m < 4; ++m) { float* p = C + (size_t)(row0 + ai * HALF + m * 16) * ldc + col0;
#pragma unroll
                for (int bj = 0; bj < 2; ++bj)
#pragma unroll
                    for (int n = 0; n < 2; ++n) *(f32x4*)(p + bj * HALF + n * 16) = acc[ai][bj][m][n]; }
    }
};
struct EpiRelu2 {
    static constexpr bool PERM = true, AFTER_DRAIN = false;
    u16* O; int ldc;
    __device__ __forceinline__ void operator()(const f32x4 (&acc)[2][2][4][2], const Unit& u, int wr, int wc, int fr, int fq) const {
        const int row0 = u.pm * BM + wr * 64 + fr, col0 = u.pn * BM + wc * 32 + 8 * fq;
#pragma unroll
        for (int ai = 0; ai < 2; ++ai)
#pragma unroll
            for (int m = 0; m < 4; ++m) { u16* p = O + (size_t)(row0 + ai * HALF + m * 16) * ldc + col0;
#pragma unroll
                for (int bj = 0; bj < 2; ++bj) { f32x4 v0 = acc[ai][bj][m][0], v1 = acc[ai][bj][m][1];
#pragma unroll
                    for (int e = 0; e < 4; ++e) { v0[e] = v0[e] > 0.f ? v0[e] * v0[e] : 0.f; v1[e] = v1[e] > 0.f ? v1[e] * v1[e] : 0.f; }
                    u32x4 w; w.x = pk_bf16(v0[0], v0[1]); w.y = pk_bf16(v0[2], v0[3]); w.z = pk_bf16(v1[0], v1[1]); w.w = pk_bf16(v1[2], v1[3]);
                    *(u32x4*)(p + bj * HALF) = w; } }
    }
};


template <bool F16> __device__ __forceinline__ f32x4 mma16(bf16x8 a, bf16x8 b, f32x4 c) {
    if constexpr (F16) return __builtin_amdgcn_mfma_f32_16x16x32_f16(__builtin_bit_cast(f16x8, a), __builtin_bit_cast(f16x8, b), c, 0, 0, 0);
    else return __builtin_amdgcn_mfma_f32_16x16x32_bf16(a, b, c, 0, 0, 0);
}
template <bool F16, class Epi, class Sched, bool ALIGN_EPI = false, bool SP2 = false>
__device__ __forceinline__ void gemm_phase(PG8_LAS unsigned char* lds, const Gemm g, const Sched& S, const Epi& E) {
    int tid_ = threadIdx.x; asm volatile("" : "+v"(tid_));
    const int tid = tid_, wid = __builtin_amdgcn_readfirstlane(tid >> 6), lane = tid & 63, wr = wid >> 2, wc = wid & 3, fr = lane & 15, fq = lane >> 4;
    const int K = g.K, nt = K / BK;
    unsigned voffA[2], voffB[2];
#pragma unroll
    for (int i = 0; i < 2; ++i) { int R, C; stage_rc(tid * 16 + i * 8192, R, C); const int Rb = Epi::PERM ? ((R & ~31) + perm32(R & 31)) : R;
        voffA[i] = (unsigned)(R * K + C) * 2u; voffB[i] = (unsigned)(Rb * K + C) * 2u; }
    const size_t kstep = (size_t)(BK * 2);
    const size_t hstep = (size_t)HALF * K * 2;
    const size_t tstep = 2 * hstep;
    const unsigned ldsw = (unsigned)wid * 1024u;
    const int aoff = lds_byte(wr * 64 + fr, fq * 8), boff = lds_byte(wc * 32 + fr, fq * 8);
#define PG8_SA(b, h) (((b) * 2 + (h)) * HTB)
#define PG8_SB(b, h) ((4 + (b) * 2 + (h)) * HTB)
#define PG8_STAGE(bufoff, gbase, voff) do { _Pragma("unroll") for (int _i = 0; _i < 2; ++_i) \
        __builtin_amdgcn_global_load_lds((const unsigned*)((const char*)(gbase) + (voff)[_i]), (PG8_LAS unsigned*)(lds + (bufoff) + ldsw + _i * 8192), 16, 0, 0); } while (0)
#define PG8_LDA(dst, b, h) do { _Pragma("unroll") for (int m = 0; m < 4; ++m) _Pragma("unroll") for (int k = 0; k < 2; ++k) dst[m][k] = *(const PG8_LAS bf16x8*)(lds + PG8_SA(b, h) + aoff + m * 2048 + k * 1024); } while (0)
#define PG8_LDB(dst, b, h) do { _Pragma("unroll") for (int n = 0; n < 2; ++n) _Pragma("unroll") for (int k = 0; k < 2; ++k) dst[n][k] = *(const PG8_LAS bf16x8*)(lds + PG8_SB(b, h) + boff + n * 2048 + k * 1024); } while (0)
#define PG8_MMA(ai, bj, At, Bt) do { __builtin_amdgcn_s_setprio(1); _Pragma("unroll") for (int m = 0; m < 4; ++m) _Pragma("unroll") for (int n = 0; n < 2; ++n) _Pragma("unroll") for (int k = 0; k < 2; ++k) \
        acc[ai][bj][m][n] = mma16<F16>(Bt[n][k], At[m][k], acc[ai][bj][m][n]); __builtin_amdgcn_s_setprio(0); } while (0)
#define PG8_WAIT_V(n) asm volatile("s_waitcnt vmcnt(" #n ")" ::: "memory")
#define PG8_WAIT_L(n) asm volatile("s_waitcnt lgkmcnt(" #n ")" ::: "memory")
#define PG8_BAR __builtin_amdgcn_s_barrier()
#define PG8_SCHED __builtin_amdgcn_sched_barrier(0)
    Unit cur, nxt; int ui = 0;
    if (!S.next(0, cur)) return;
    f32x4 acc[2][2][4][2];
#pragma unroll
    for (int a = 0; a < 2; ++a)
#pragma unroll
        for (int b = 0; b < 2; ++b)
#pragma unroll
            for (int m = 0; m < 4; ++m)
#pragma unroll
                for (int n = 0; n < 2; ++n) acc[a][b][m][n] = (f32x4){0.f, 0.f, 0.f, 0.f};
    bf16x8 At[4][2], B0[2][2], B1[2][2];
    const char* cA = (const char*)g.A + (size_t)cur.pm * tstep; const char* cB = (const char*)g.Bt + (size_t)cur.pn * tstep;
    S.a_ready(cur);
    if constexpr (SP2) {
        PG8_STAGE(PG8_SB(0, 0), cB, voffB); PG8_STAGE(PG8_SB(0, 1), cB + hstep, voffB); PG8_STAGE(PG8_SA(0, 0), cA, voffA); PG8_STAGE(PG8_SA(0, 1), cA + hstep, voffA);
        if (wr == 1) PG8_BAR;
        PG8_WAIT_V(2); PG8_BAR;
        PG8_STAGE(PG8_SB(1, 0), cB + kstep, voffB); PG8_STAGE(PG8_SA(1, 0), cA + kstep, voffA); PG8_STAGE(PG8_SB(1, 1), cB + hstep + kstep, voffB);
        PG8_WAIT_V(6); PG8_BAR;
    } else {
        PG8_STAGE(PG8_SB(0, 0), cB, voffB); PG8_STAGE(PG8_SA(0, 0), cA, voffA); PG8_STAGE(PG8_SB(0, 1), cB + hstep, voffB); PG8_STAGE(PG8_SA(0, 1), cA + hstep, voffA);
        if (wr == 1) PG8_BAR;
        PG8_WAIT_V(4); PG8_BAR;
        PG8_STAGE(PG8_SB(1, 0), cB + kstep, voffB); PG8_STAGE(PG8_SA(1, 0), cA + kstep, voffA); PG8_STAGE(PG8_SB(1, 1), cB + hstep + kstep, voffB);
        PG8_WAIT_V(6); PG8_BAR;
    }
    for (;;) {
        const bool has_next = S.next(ui + 1, nxt);
        const char* nA = has_next ? (const char*)g.A + (size_t)nxt.pm * tstep : cA; const char* nB = has_next ? (const char*)g.Bt + (size_t)nxt.pn * tstep : cB;
        for (int t = 0; t < nt; t += 2) {
            const bool last = (t == nt - 2);
            const char* a1 = cA + (size_t)(t + 1) * kstep;
            const char* a2 = last ? nA : cA + (size_t)(t + 2) * kstep; const char* b2 = last ? nB : cB + (size_t)(t + 2) * kstep;
            const char* a3 = a2 + kstep; const char* b3 = b2 + kstep;
            if (last && has_next) S.a_ready(nxt);
            if constexpr (SP2) {
            PG8_LDB(B0, 0, 0); PG8_LDB(B1, 0, 1); PG8_SCHED; PG8_LDA(At, 0, 0); PG8_STAGE(PG8_SA(1, 1), a1 + hstep, voffA);
            PG8_WAIT_V(8); PG8_WAIT_L(0); PG8_BAR; PG8_MMA(0, 0, At, B0); PG8_MMA(0, 1, At, B1); PG8_BAR; PG8_SCHED;
            PG8_LDA(At, 0, 1); PG8_STAGE(PG8_SB(0, 0), b2, voffB); PG8_STAGE(PG8_SB(0, 1), b2 + hstep, voffB); PG8_STAGE(PG8_SA(0, 0), a2, voffA);
            PG8_WAIT_V(8); PG8_WAIT_L(0); PG8_BAR; PG8_MMA(1, 0, At, B0); PG8_MMA(1, 1, At, B1); PG8_BAR; PG8_SCHED;
            PG8_LDB(B0, 1, 0); PG8_LDB(B1, 1, 1); PG8_SCHED; PG8_LDA(At, 1, 0); PG8_STAGE(PG8_SA(0, 1), a2 + hstep, voffA);
            PG8_WAIT_V(8); PG8_WAIT_L(0); PG8_BAR; PG8_MMA(0, 0, At, B0); PG8_MMA(0, 1, At, B1); PG8_BAR; PG8_SCHED;
            PG8_LDA(At, 1, 1); PG8_STAGE(PG8_SB(1, 0), b3, voffB); PG8_STAGE(PG8_SB(1, 1), b3 + hstep, voffB); PG8_STAGE(PG8_SA(1, 0), a3, voffA);
            PG8_WAIT_V(8); PG8_WAIT_L(0); PG8_BAR; PG8_MMA(1, 0, At, B0); PG8_MMA(1, 1, At, B1); PG8_BAR; PG8_SCHED;
            } else {
            PG8_LDB(B0, 0, 0); PG8_SCHED; PG8_LDA(At, 0, 0); PG8_STAGE(PG8_SA(1, 1), a1 + hstep, voffA);
            PG8_WAIT_L(8); PG8_BAR; PG8_WAIT_L(0); PG8_MMA(0, 0, At, B0); PG8_BAR; PG8_SCHED;
            PG8_LDB(B1, 0, 1); PG8_STAGE(PG8_SB(0, 0), b2, voffB);
            PG8_BAR; PG8_WAIT_L(0); PG8_MMA(0, 1, At, B1); PG8_BAR;
            PG8_LDA(At, 0, 1); PG8_STAGE(PG8_SA(0, 0), a2, voffA);
            PG8_BAR; PG8_WAIT_L(0); PG8_MMA(1, 0, At, B0); PG8_BAR; PG8_SCHED;
            PG8_STAGE(PG8_SB(0, 1), b2 + hstep, voffB);
            PG8_WAIT_V(6); PG8_BAR; PG8_MMA(1, 1, At, B1); PG8_BAR;
            PG8_LDB(B0, 1, 0); PG8_SCHED; PG8_LDA(At, 1, 0); PG8_STAGE(PG8_SA(0, 1), a2 + hstep, voffA);
            PG8_WAIT_L(8); PG8_BAR; PG8_WAIT_L(0); PG8_MMA(0, 0, At, B0); PG8_BAR; PG8_SCHED;
            PG8_LDB(B1, 1, 1); PG8_STAGE(PG8_SB(1, 0), b3, voffB);
            PG8_BAR; PG8_WAIT_L(0); PG8_MMA(0, 1, At, B1); PG8_BAR;
            PG8_LDA(At, 1, 1); PG8_STAGE(PG8_SA(1, 0), a3, voffA);
            PG8_BAR; PG8_WAIT_L(0); PG8_MMA(1, 0, At, B0); PG8_BAR; PG8_SCHED;
            PG8_STAGE(PG8_SB(1, 1), b3 + hstep, voffB);
            PG8_WAIT_V(6); PG8_BAR; PG8_MMA(1, 1, At, B1); PG8_BAR;
            }
        }
        if constexpr (ALIGN_EPI) { if (wr == 0) PG8_BAR; }
        if constexpr (!Epi::AFTER_DRAIN) { E(acc, cur, wr, wc, fr, fq); S.done(cur); }
        if (!has_next) break;
#pragma unroll
        for (int a = 0; a < 2; ++a)
#pragma unroll
            for (int b = 0; b < 2; ++b)
#pragma unroll
                for (int m = 0; m < 4; ++m)
#pragma unroll
                    for (int n = 0; n < 2; ++n) acc[a][b][m][n] = (f32x4){0.f, 0.f, 0.f, 0.f};
        cur = nxt; cA = nA; cB = nB; ++ui;
        if constexpr (ALIGN_EPI) { if (wr == 1) PG8_BAR; }
    }
    PG8_WAIT_V(0);
    if constexpr (!ALIGN_EPI) { if (wr == 0) PG8_BAR; }
    PG8_BAR;
    if constexpr (Epi::AFTER_DRAIN) { E.fused(acc, cur, wr, wc, fr, fq, lds, wid, lane); S.done(cur); }
#undef PG8_SA
#undef PG8_SB
#undef PG8_STAGE
#undef PG8_LDA
#undef PG8_LDB
#undef PG8_MMA
#undef PG8_WAIT_V
#undef PG8_WAIT_L
#undef PG8_BAR
#undef PG8_SCHED
}
}


#define GAS __attribute__((address_space(1)))
#define LAS __attribute__((address_space(3)))
typedef unsigned v4u __attribute__((ext_vector_type(4)));
typedef float f32x4 __attribute__((ext_vector_type(4)));
typedef GAS unsigned gu32;
typedef GAS unsigned long long gu64;
#define RLX_AGENT __ATOMIC_RELAXED, __HIP_MEMORY_SCOPE_AGENT
#define LDS_WAIT() asm volatile("s_waitcnt lgkmcnt(0)" ::: "memory")
#define VM_WAIT() asm volatile("s_waitcnt vmcnt(0)" ::: "memory")


#define XB_TMO      128
#define XB_XCNT(j)  (256  + 64 * (j))
#define XB_XSUB(j)  (1280 + 64 * (j))
#define XB_XGEN(j)  (2304 + 64 * (j))
#define XB_TOP      3328
#define XB_TOPGEN   3392
#define XCD_BAR_WORDS 3456
#define XB_SPIN_CAP (1u << 18)

__device__ __forceinline__ unsigned xb_ld(unsigned* p)              { return __hip_atomic_load(p, __ATOMIC_RELAXED, __HIP_MEMORY_SCOPE_AGENT); }
__device__ __forceinline__ unsigned xb_add(unsigned* p, unsigned v) { return __hip_atomic_fetch_add(p, v, __ATOMIC_RELAXED, __HIP_MEMORY_SCOPE_AGENT); }
__device__ __forceinline__ unsigned xb_xcc_id() { return (unsigned)__builtin_amdgcn_s_getreg((3 << 11) | 20) & 0xFu; }
#define XB_SPIN(cond, bar) do { unsigned _sp = 0; while (cond) { __builtin_amdgcn_s_sleep(1); \
    if ((++_sp & 255u) == 0u) { if (xb_ld(&(bar)[XB_TMO])) break; if (_sp > XB_SPIN_CAP) { atomicAdd(&(bar)[XB_TMO], 1u); break; } } } } while (0)

struct XcdBarrier {
    unsigned* bar; unsigned x;
    volatile LAS unsigned* st;
};

__device__ __forceinline__ XcdBarrier xcd_barrier_post(unsigned* bar, volatile LAS unsigned* st) {
    XcdBarrier b; b.bar = bar; b.x = xb_xcc_id(); b.st = st;
    if (threadIdx.x == 0) (void)xb_add(&bar[XB_XCNT(b.x)], 1u);
    return b;
}
__device__ __forceinline__ void xcd_barrier_complete(unsigned* bar, unsigned x, unsigned& nloc, unsigned& nx) {
    const unsigned G = gridDim.x * gridDim.y * gridDim.z;
    unsigned sum, cnt, mine, sp = 0u;
    for (;;) {
        sum = 0u; cnt = 0u; mine = 0u;
#pragma unroll
        for (unsigned j = 0; j < 16; ++j) { const unsigned c = xb_ld(&bar[XB_XCNT(j)]); sum += c; cnt += (c > 0u) ? 1u : 0u; mine = (j == x) ? c : mine; }
        if (sum == G) break;
        __builtin_amdgcn_s_sleep(1);
        if ((++sp & 255u) == 0u) { if (xb_ld(&bar[XB_TMO])) break; if (sp > XB_SPIN_CAP) { atomicAdd(&bar[XB_TMO], 1u); break; } }
    }
    nloc = mine > 0u ? mine : 1u; nx = cnt > 0u ? cnt : 1u;
}

__device__ __forceinline__ void xcd_barrier(const XcdBarrier& b) {
    asm volatile("s_waitcnt vmcnt(0)" ::: "memory");
    __syncthreads();
    if (threadIdx.x == 0) {
        unsigned* bar = b.bar;
        __builtin_amdgcn_s_waitcnt(0);
        unsigned nloc = b.st[0], nx = b.st[1];
        if (nloc == 0u) { xcd_barrier_complete(bar, b.x, nloc, nx); b.st[0] = nloc; b.st[1] = nx; }
        const unsigned old = xb_add(&bar[XB_XSUB(b.x)], 1u);
        const unsigned gen = old / nloc;
        if (old + 1u == (gen + 1u) * nloc) {
            __builtin_amdgcn_fence(__ATOMIC_RELEASE, "agent");
            asm volatile("s_waitcnt vmcnt(0)" ::: "memory");
            const unsigned og = xb_add(&bar[XB_TOP], 1u);
            const unsigned tg = og / nx;
            if (og + 1u == (tg + 1u) * nx) xb_add(&bar[XB_TOPGEN], 1u);
            else XB_SPIN(xb_ld(&bar[XB_TOPGEN]) == tg, bar);
            __builtin_amdgcn_fence(__ATOMIC_ACQUIRE, "agent");
            xb_add(&bar[XB_XGEN(b.x)], 1u);
            asm volatile("s_waitcnt vmcnt(0)" ::: "memory");
        } else {
            XB_SPIN(xb_ld(&bar[XB_XGEN(b.x)]) == gen, bar);
            __builtin_amdgcn_fence(__ATOMIC_ACQUIRE, "agent");
            asm volatile("s_waitcnt vmcnt(0)" ::: "memory");
        }
    }
    __syncthreads();
}

namespace att {
typedef _Float16 f16x8 __attribute__((ext_vector_type(8)));
typedef short s16x4 __attribute__((ext_vector_type(4)));
typedef short s16x8 __attribute__((ext_vector_type(8)));
typedef float f32x16 __attribute__((ext_vector_type(16)));
typedef unsigned u32x4 __attribute__((ext_vector_type(4)));
typedef __attribute__((address_space(3))) unsigned char* lds_ptr;
typedef __attribute__((address_space(3))) const unsigned char* lds_cptr;
constexpr int NW = 8, QBLK = 32, QB = 256, KVBLK = 64, NSLOT = 3;
constexpr int KSLOTB = 12288, VSLOTB = 8192;
constexpr int LDS_K = 0, LDS_V = NSLOT * KSLOTB, LDS_WS = LDS_V + NSLOT * VSLOTB, LDS_OST = LDS_WS + NW * 256, LDS_KM = LDS_OST + NW * 4096, LDS_BYTES = LDS_KM + 16 * 64 * 4;
__device__ __forceinline__ int crow(int r, int hi) { return (r & 3) + 8 * (r >> 2) + 4 * hi; }
__device__ __forceinline__ void glds16(const void* gsrc, unsigned lds_dst) { unsigned keep;
    asm volatile("s_mov_b32 %0, m0\n\ts_mov_b32 m0, %2\n\ts_nop 0\n\tglobal_load_lds_dwordx4 %1, off\n\ts_mov_b32 m0, %0" : "=&s"(keep) : "v"(gsrc), "s"(lds_dst) : "memory"); }
__device__ __forceinline__ f32x16 mma32(s16x8 a, s16x8 b, f32x16 c) { return __builtin_amdgcn_mfma_f32_32x32x16_f16(__builtin_bit_cast(f16x8, a), __builtin_bit_cast(f16x8, b), c, 0, 0, 0); }
typedef short v4i16_t __attribute__((ext_vector_type(4)));
__device__ __forceinline__ s16x4 vtr(lds_cptr p) { return __builtin_bit_cast(s16x4, __builtin_amdgcn_ds_read_tr16_b64_v4i16((__attribute__((address_space(3))) v4i16_t*)p)); }
__device__ __forceinline__ float max3f(float a, float b, float c) { float r; asm("v_max3_f32 %0, %1, %2, %3" : "=v"(r) : "v"(a), "v"(b), "v"(c)); return r; }
__device__ __forceinline__ float xhalf_max(float m) { auto rr = __builtin_amdgcn_permlane32_swap(__float_as_uint(m), __float_as_uint(m), false, false); return fmaxf(__uint_as_float(rr[0]), __uint_as_float(rr[1])); }
__device__ __forceinline__ float xhalf_sum(float m) { auto rr = __builtin_amdgcn_permlane32_swap(__float_as_uint(m), __float_as_uint(m), false, false); return __uint_as_float(rr[0]) + __uint_as_float(rr[1]); }
__device__ __forceinline__ float rowmax32(const f32x16& p0, const f32x16& p1) {
    float a = max3f(p0[0], p0[1], p1[0]), b = max3f(p0[2], p0[3], p1[1]); a = max3f(a, p1[2], p1[3]);
#pragma unroll
    for (int r = 4; r < 16; r += 4) { a = max3f(a, p0[r], p0[r + 1]); b = max3f(b, p0[r + 2], p0[r + 3]); a = max3f(a, p1[r], p1[r + 1]); b = max3f(b, p1[r + 2], p1[r + 3]); }
    return xhalf_max(fmaxf(a, b));
}
constexpr float THR = 8.0f;

struct Tensors { const h16 *QN, *QR, *KN, *KR, *VA, *QM, *KM, *VM; const float* kmean; h16* MIX; };

template <int KD, bool MOBA>
__device__ __forceinline__ void attn_unit(int b, int h, int qb, const Tensors& T, lds_ptr shm) {
    int tid_ = threadIdx.x; asm volatile("" : "+v"(tid_));
    const int tid = tid_, lane = tid & 63, r32 = lane & 31, hi = lane >> 5; const int wid = __builtin_amdgcn_readfirstlane(tid >> 6);
    const size_t rowbase = (size_t)b * SEQ; const int q0 = qb * QB;
    const unsigned lds0 = (unsigned)(uintptr_t)shm;
    const h16* Kh = (MOBA ? T.KM : T.KN) + rowbase * 512 + h * 64;
    const h16* Vh = (MOBA ? T.VM : T.VA) + rowbase * 512 + h * 64;
    const h16* KRb = T.KR + rowbase * 32;
    const h16* ksrc = Kh + (size_t)lane * 512 + wid * 8;
    const h16* ksrc2 = KRb + (size_t)lane * 32 + (wid & 3) * 8;
    const h16* vsrc = Vh + (size_t)(16 * (wid & 3) + (lane >> 2)) * 512 + (wid >> 2) * 32 + (lane & 3) * 8;
    const unsigned kdst = lds0 + LDS_K + wid * 1024, kdst2 = lds0 + LDS_K + (8 + (wid & 3)) * 1024, vdst = lds0 + LDS_V + wid * 1024;
    const bool extra = (KD == 6) && (wid < 4);
#define ATT_DMA(t, s) do { glds16(ksrc + (size_t)(t) * KVBLK * 512, (unsigned)__builtin_amdgcn_readfirstlane(kdst + (s) * KSLOTB)); \
        if (extra) glds16(ksrc2 + (size_t)(t) * KVBLK * 32, (unsigned)__builtin_amdgcn_readfirstlane(kdst2 + (s) * KSLOTB)); \
        glds16(vsrc + (size_t)(t) * KVBLK * 512, (unsigned)__builtin_amdgcn_readfirstlane(vdst + (s) * VSLOTB)); } while (0)
    const int NT = (q0 + QB) / KVBLK;
    asm volatile("s_waitcnt vmcnt(0)" ::: "memory");
    __builtin_amdgcn_s_barrier();
    if (MOBA) { for (int e = tid; e < 16 * 64; e += NW * 64) { const int n = e >> 6, d = e & 63; const size_t idx = ((size_t)b * 16 + n) * 512 + h * 64 + d;
            ((__attribute__((address_space(3))) float*)(shm + LDS_KM))[e] = T.kmean[idx] + T.kmean[(size_t)NB * 16 * 512 + idx]; } }
    const size_t qrow = rowbase + q0 + wid * QBLK + r32;
    s16x8 qr[KD];
    if (MOBA) {
#pragma unroll
        for (int d0 = 0; d0 < 4; ++d0) qr[d0] = *(const s16x8*)(T.QM + qrow * 512 + h * 64 + d0 * 16 + hi * 8);
    } else {
#pragma unroll
        for (int d0 = 0; d0 < 4; ++d0) qr[d0] = *(const s16x8*)(T.QN + qrow * 512 + h * 64 + d0 * 16 + hi * 8);
#pragma unroll
        for (int d0 = 4; d0 < KD; ++d0) qr[d0] = *(const s16x8*)(T.QR + qrow * 256 + h * 32 + (d0 - 4) * 16 + hi * 8);
    }
    asm volatile("s_waitcnt vmcnt(0)" ::: "memory");
    ATT_DMA(0, 0); if (NT > 1) ATT_DMA(1, 1);
    __attribute__((address_space(3))) float* wsf = (__attribute__((address_space(3))) float*)(shm + LDS_WS) + wid * 64;
    const int qrel = wid * QBLK + r32;
    unsigned sel = 0u;
    float mhat = 0.f, l_reg = 0.f; bool started = false; f32x16 o[2]; o[0] = f32x16{}; o[1] = f32x16{};
    f32x16 negm = f32x16{}, cmsk = f32x16{};
    const int vboff = ((lane >> 4) & 1) * 32 + (lane & 3) * 8 + (4 * hi + ((lane & 15) >> 2)) * 64;
    int slot = 0;
    for (int t = 0; t < NT; ++t) {
        if (t + 1 < NT) { if (extra) asm volatile("s_waitcnt vmcnt(3)" ::: "memory"); else asm volatile("s_waitcnt vmcnt(2)" ::: "memory"); }
        else asm volatile("s_waitcnt vmcnt(0)" ::: "memory");
        asm volatile("s_waitcnt lgkmcnt(0)\n\ts_barrier" ::: "memory");
        if (t + 2 < NT) { const int s2 = slot == 0 ? 2 : slot - 1; ATT_DMA(t + 2, s2); }
        if (MOBA && t == 0 && qb > 0) {
            const __attribute__((address_space(3))) float* km = (const __attribute__((address_space(3))) float*)(shm + LDS_KM);
            float g[8];
#pragma unroll
            for (int i = 0; i < 8; ++i) g[i] = 0.f;
#pragma unroll
            for (int c = 0; c < 8; ++c) { const s16x8 qv = *(const s16x8*)(T.QM + qrow * 512 + h * 64 + c * 8); const f16x8 qh = __builtin_bit_cast(f16x8, qv);
#pragma unroll
                for (int i = 0; i < 8; ++i) { const int n = 2 * i + hi;
#pragma unroll
                    for (int e = 0; e < 8; ++e) g[i] += (float)qh[e] * km[n * 64 + c * 8 + e]; } }
            float ga[16];
#pragma unroll
            for (int i = 0; i < 8; ++i) { const float other = __shfl_xor(g[i], 32); ga[2 * i] = hi ? other : g[i]; ga[2 * i + 1] = hi ? g[i] : other; }
#pragma unroll
            for (int k = 0; k < 3; ++k) { float best = -INFINITY; int bi = -1;
#pragma unroll
                for (int n = 0; n < 16; ++n) if (n < qb && !((sel >> n) & 1u) && ga[n] > best) { best = ga[n]; bi = n; }
                if (bi >= 0) sel |= 1u << bi; }
        }
        const int jb = t - (NT - 4);
        const bool own = jb >= 0;
        const bool dead = own && (64 * jb > wid * QBLK + 31);
        if (!dead) {
            const lds_cptr kp = (lds_cptr)shm + LDS_K + slot * KSLOTB + hi * 1024 + r32 * 16;
            if (MOBA && (t & 3) == 0) { const bool ok = own || ((sel >> (t >> 2)) & 1u);
#pragma unroll
                for (int r = 0; r < 16; ++r) cmsk[r] = ok ? negm[r] : -INFINITY; }
            f32x16 p0, p1;
#pragma unroll
            for (int d0 = 0; d0 < KD; ++d0) {
                const s16x8 k0 = *(const __attribute__((address_space(3))) s16x8*)(kp + d0 * 2048);
                const s16x8 k1 = *(const __attribute__((address_space(3))) s16x8*)(kp + d0 * 2048 + 512);
                if (d0 == 0) { p0 = mma32(k0, qr[0], MOBA ? cmsk : negm); p1 = mma32(k1, qr[0], MOBA ? cmsk : negm); }
                else { p0 = mma32(k0, qr[d0], p0); p1 = mma32(k1, qr[d0], p1); }
            }
            if (own && (64 * jb + 63 > wid * QBLK)) {
                const int kb = 64 * jb + 4 * hi;
#pragma unroll
                for (int r = 0; r < 16; ++r) { const int kv = kb + (r & 3) + 8 * (r >> 2); if (kv > qrel) p0[r] = -INFINITY; if (kv + 32 > qrel) p1[r] = -INFINITY; }
            }
            const float rm = rowmax32(p0, p1);
            const bool need = started ? (rm > THR) : (rm > -INFINITY);
            if (__any(need)) {
                const float dl = need ? rm : 0.f, f = (need && started) ? __builtin_amdgcn_exp2f(-dl) : 1.0f;
                mhat += dl; started = started || need; l_reg *= f;
#pragma unroll
                for (int r = 0; r < 16; ++r) { p0[r] -= dl; p1[r] -= dl; negm[r] = -mhat; }
                if (MOBA) { const bool ok = own || ((sel >> (t >> 2)) & 1u);
#pragma unroll
                    for (int r = 0; r < 16; ++r) cmsk[r] = ok ? negm[r] : -INFINITY; }
                if (hi == 0) wsf[r32] = f;
                asm volatile("s_waitcnt lgkmcnt(0)" ::: "memory");
#pragma unroll
                for (int r = 0; r < 16; ++r) { const float ff = wsf[crow(r, hi)]; o[0][r] *= ff; o[1][r] *= ff; }
                asm volatile("s_waitcnt lgkmcnt(0)" ::: "memory");
            }
            float rs = 0.f;
#pragma unroll
            for (int r = 0; r < 16; ++r) { p0[r] = __builtin_amdgcn_exp2f(p0[r]); p1[r] = __builtin_amdgcn_exp2f(p1[r]); rs += p0[r] + p1[r]; }
            l_reg += rs;
            u32x4 pw[4];
#pragma unroll
            for (int i = 0; i < 4; ++i) { pw[0][i] = pk_h16(p0[2 * i], p0[2 * i + 1]); pw[1][i] = pk_h16(p0[8 + 2 * i], p0[9 + 2 * i]); pw[2][i] = pk_h16(p1[2 * i], p1[2 * i + 1]); pw[3][i] = pk_h16(p1[8 + 2 * i], p1[9 + 2 * i]); }
            const lds_cptr vp = (lds_cptr)shm + LDS_V + slot * VSLOTB + vboff;
#pragma unroll
            for (int d0 = 0; d0 < 2; ++d0)
#pragma unroll
                for (int ks = 0; ks < 4; ++ks) { const s16x4 lo = vtr(vp + d0 * 4096 + ks * 1024), hh = vtr(vp + d0 * 4096 + ks * 1024 + 512);
                    const s16x8 vf = {lo[0], lo[1], lo[2], lo[3], hh[0], hh[1], hh[2], hh[3]};
                    o[d0] = mma32(__builtin_bit_cast(s16x8, pw[ks]), vf, o[d0]); }
        }
        slot = slot == 2 ? 0 : slot + 1;
    }
    l_reg = xhalf_sum(l_reg);
    if (hi == 0) wsf[32 + r32] = l_reg;
    asm volatile("s_waitcnt lgkmcnt(0)" ::: "memory");
    h16* Ow = T.MIX + (rowbase + q0 + wid * QBLK) * 1024 + (MOBA ? 512 : 0) + h * 64;
    { __attribute__((address_space(3))) h16* stg = (__attribute__((address_space(3))) h16*)(shm + LDS_OST) + wid * 2048;
#pragma unroll
        for (int r = 0; r < 16; ++r) { const int orow = crow(r, hi); const float rl = 1.0f / wsf[32 + orow];
#pragma unroll
            for (int d0 = 0; d0 < 2; ++d0) stg[orow * 64 + d0 * 32 + r32] = (h16)(o[d0][r] * rl); }
        asm volatile("s_waitcnt lgkmcnt(0)" ::: "memory");
#pragma unroll
        for (int i = 0; i < 4; ++i) { const int row = i * 8 + (lane >> 3), ch = lane & 7; const u32x4 v = *(const __attribute__((address_space(3))) u32x4*)(stg + row * 64 + ch * 8); *(u32x4*)(Ow + (size_t)row * 1024 + ch * 8) = v; } }
    asm volatile("s_waitcnt lgkmcnt(0)\n\ts_barrier" ::: "memory");
#undef ATT_DMA
}
__device__ __forceinline__ void attn_phase(int vcu, const Tensors& T, lds_ptr shm) {
    const int bh = vcu >> 2, sub = vcu & 3, b = bh >> 3, h = bh & 7;
    for (int i = 0; i < 4; ++i) { const int s = 2 * sub + (i >> 1), qb = (i & 1) ? 15 - s : s; attn_unit<6, false>(b, h, qb, T, shm); }
    for (int i = 0; i < 4; ++i) { const int s = 2 * sub + (i >> 1), qb = (i & 1) ? 15 - s : s; attn_unit<4, true>(b, h, qb, T, shm); }
}
}


namespace att {
constexpr int PSLOT = 8192, P_K = 0, P_V = 3 * PSLOT, P_KR = 6 * PSLOT, P_WS = P_KR + 3 * 4096, P_OST = P_WS + NW * 256, P_KM = P_OST + NW * 4096, P_BYTES = P_KM + 16 * 64 * 4;
#define SBAR() __builtin_amdgcn_sched_barrier(0)
#define WAIT_BAR(N) asm volatile("s_waitcnt vmcnt(" #N ") lgkmcnt(0)\n\ts_barrier" ::: "memory")
typedef __attribute__((address_space(3))) const s16x8* lds_k8;
__device__ __forceinline__ void kload2(s16x8* kf, lds_cptr kp, int j) { kf[2 * j] = *(lds_k8)(kp + j * 2048); kf[2 * j + 1] = *(lds_k8)(kp + j * 2048 + 512); }

template <int KD, bool MOBA>
__device__ __forceinline__ void attn_unit_p(int b, int h, int qb, const Tensors& T, lds_ptr shm) {
    int tid_ = threadIdx.x; asm volatile("" : "+v"(tid_));
    const int tid = tid_, lane = tid & 63, r32 = lane & 31, hi = lane >> 5; const int wid = __builtin_amdgcn_readfirstlane(tid >> 6);
    const size_t rowbase = (size_t)b * SEQ; const int q0 = qb * QB;
    const unsigned lds0 = (unsigned)(uintptr_t)shm;
    const h16* Kh = (MOBA ? T.KM : T.KN) + rowbase * 512 + h * 64;
    const h16* Vh = (MOBA ? T.VM : T.VA) + rowbase * 512 + h * 64;
    const h16* ksrc = Kh + (size_t)lane * 512 + wid * 8;
    const h16* ksrc2 = T.KR + rowbase * 32 + (size_t)lane * 32 + (wid & 3) * 8;
    const h16* vsrc = Vh + (size_t)(16 * (wid & 3) + (lane >> 2)) * 512 + (wid >> 2) * 32 + (lane & 3) * 8;
    const unsigned kdst = lds0 + P_K + wid * 1024, kdst2 = lds0 + P_KR + (wid & 3) * 1024, vdst = lds0 + P_V + wid * 1024;
    const bool extra = (KD == 6) && (wid < 4);
#define DMA_K(t, so) glds16(ksrc + (size_t)(t) * KVBLK * 512, (unsigned)__builtin_amdgcn_readfirstlane(kdst + (so)))
#define DMA_V(t, so) glds16(vsrc + (size_t)(t) * KVBLK * 512, (unsigned)__builtin_amdgcn_readfirstlane(vdst + (so)))
#define DMA_R(t, so) do { if (extra) glds16(ksrc2 + (size_t)(t) * KVBLK * 32, (unsigned)__builtin_amdgcn_readfirstlane(kdst2 + ((so) >> 1))); } while (0)
#define WAIT_BAR_X(N, NX) do { if (extra) { WAIT_BAR(NX); } else { WAIT_BAR(N); } } while (0)
    const lds_cptr shm3 = (lds_cptr)shm;
    const lds_cptr kp0 = shm3 + P_K + hi * 1024 + r32 * 16, krp0 = shm3 + P_KR + hi * 1024 + r32 * 16;
    const int vboff = ((lane >> 4) & 1) * 32 + (lane & 3) * 8 + (4 * hi + ((lane & 15) >> 2)) * 64;
    const lds_cptr vp0 = shm3 + P_V + vboff;
    __attribute__((address_space(3))) float* wsf = (__attribute__((address_space(3))) float*)(shm + P_WS) + wid * 64;
    const int NT = (q0 + QB) / KVBLK;
    asm volatile("s_waitcnt vmcnt(0)" ::: "memory");
    __builtin_amdgcn_s_barrier();
    if (MOBA) { for (int e = tid; e < 16 * 64; e += NW * 64) { const int n = e >> 6, d = e & 63; const size_t idx = ((size_t)b * 16 + n) * 512 + h * 64 + d;
            ((__attribute__((address_space(3))) float*)(shm + P_KM))[e] = T.kmean[idx] + T.kmean[(size_t)NB * 16 * 512 + idx]; } }
    const size_t qrow = rowbase + q0 + wid * QBLK + r32;
    s16x8 qr[KD];
    if (MOBA) {
#pragma unroll
        for (int d0 = 0; d0 < 4; ++d0) qr[d0] = *(const s16x8*)(T.QM + qrow * 512 + h * 64 + d0 * 16 + hi * 8);
    } else {
#pragma unroll
        for (int d0 = 0; d0 < 4; ++d0) qr[d0] = *(const s16x8*)(T.QN + qrow * 512 + h * 64 + d0 * 16 + hi * 8);
#pragma unroll
        for (int d0 = 4; d0 < KD; ++d0) qr[d0] = *(const s16x8*)(T.QR + qrow * 256 + h * 32 + (d0 - 4) * 16 + hi * 8);
    }
    unsigned sel = 0u;
    if (MOBA && qb > 0) {
        asm volatile("s_waitcnt vmcnt(0) lgkmcnt(0)\n\ts_barrier" ::: "memory");
        const __attribute__((address_space(3))) float* km = (const __attribute__((address_space(3))) float*)(shm + P_KM);
        float g[8];
#pragma unroll
        for (int i = 0; i < 8; ++i) g[i] = 0.f;
#pragma unroll
        for (int c = 0; c < 8; ++c) { const f16x8 qh = __builtin_bit_cast(f16x8, *(const s16x8*)(T.QM + qrow * 512 + h * 64 + c * 8));
#pragma unroll
            for (int i = 0; i < 8; ++i) { const int n = 2 * i + hi;
#pragma unroll
                for (int e = 0; e < 8; ++e) g[i] += (float)qh[e] * km[n * 64 + c * 8 + e]; } }
        float ga[16];
#pragma unroll
        for (int i = 0; i < 8; ++i) { const float other = __shfl_xor(g[i], 32); ga[2 * i] = hi ? other : g[i]; ga[2 * i + 1] = hi ? g[i] : other; }
#pragma unroll
        for (int k = 0; k < 3; ++k) { float best = -INFINITY; int bi = -1;
#pragma unroll
            for (int n = 0; n < 16; ++n) if (n < qb && !((sel >> n) & 1u) && ga[n] > best) { best = ga[n]; bi = n; }
            if (bi >= 0) sel |= 1u << bi; }
    }
    sel |= 1u << qb;
    asm volatile("s_waitcnt vmcnt(0)" ::: "memory");
    DMA_K(0, 0); DMA_R(0, 0); DMA_V(0, 0); DMA_K(1, PSLOT); DMA_R(1, PSLOT); DMA_K(2, 2 * PSLOT);
    float mhat = 0.f, l_reg = 0.f; bool started = false; f32x16 o[2]; o[0] = f32x16{}; o[1] = f32x16{};
    f32x16 negm = f32x16{}; asm volatile("" : "+v"(negm));
    f32x16 cmsk = f32x16{};
    const int qrel = wid * QBLK + r32;
    bool resc = false;
#define SETC(tt) do { if (MOBA) { const bool ok_ = (sel >> ((tt) >> 2)) & 1u; _Pragma("unroll") for (int r = 0; r < 16; ++r) cmsk[r] = ok_ ? negm[r] : -INFINITY; } } while (0)
#define CIN (MOBA ? cmsk : negm)
#define CMASKB(P0, P1, t) do { const int jb_ = (t) - (NT - 4); if (jb_ >= 0) { const int kb_ = 64 * jb_ + 4 * hi; \
        _Pragma("unroll") for (int r = 0; r < 16; ++r) { const int kv_ = kb_ + (r & 3) + 8 * (r >> 2); if (kv_ > qrel) P0[r] = -INFINITY; if (kv_ + 32 > qrel) P1[r] = -INFINITY; } } } while (0)
#define DECIDE(C0, C1, t) do { const float rm_ = rowmax32(C0, C1); resc = false; \
        const bool need_ = started ? (rm_ > THR) : (rm_ > -INFINITY); \
        if (__builtin_expect(__any(need_), 0)) { const float dl_ = need_ ? rm_ : 0.f, f_ = (need_ && started) ? __builtin_amdgcn_exp2f(-dl_) : 1.0f; \
            mhat += dl_; started = started || need_; l_reg *= f_; \
            _Pragma("unroll") for (int r = 0; r < 16; ++r) { C0[r] -= dl_; C1[r] -= dl_; } \
            _Pragma("unroll") for (int r = 0; r < 16; ++r) negm[r] = -mhat; asm volatile("" : "+v"(negm)); \
            SETC(t); if (hi == 0) wsf[r32] = f_; resc = true; } } while (0)
#define RESC() do { if (resc) { asm volatile("s_waitcnt lgkmcnt(0)" ::: "memory"); \
        _Pragma("unroll") for (int d_ = 0; d_ < 2; ++d_) _Pragma("unroll") for (int r = 0; r < 16; ++r) o[d_][r] *= wsf[crow(r, hi)]; } } while (0)
    f32x16 pA0, pA1, pB0, pB1;
    int sl_prev = 0, sl_cur = 0, sl_next = PSLOT;
#define ROT() do { sl_prev = sl_cur; sl_cur = sl_next; sl_next = (sl_next == 2 * PSLOT) ? 0 : sl_next + PSLOT; } while (0)
    WAIT_BAR_X(3, 4);
    SETC(0);
    {
#pragma unroll
        for (int d0 = 0; d0 < 4; ++d0) { const s16x8 k0 = *(lds_k8)(kp0 + d0 * 2048), k1 = *(lds_k8)(kp0 + d0 * 2048 + 512);
            if (d0 == 0) { pA0 = mma32(k0, qr[0], CIN); pA1 = mma32(k1, qr[0], CIN); } else { pA0 = mma32(k0, qr[d0], pA0); pA1 = mma32(k1, qr[d0], pA1); } }
#pragma unroll
        for (int d0 = 4; d0 < KD; ++d0) { const s16x8 k0 = *(lds_k8)(krp0 + (d0 - 4) * 2048), k1 = *(lds_k8)(krp0 + (d0 - 4) * 2048 + 512); pA0 = mma32(k0, qr[d0], pA0); pA1 = mma32(k1, qr[d0], pA1); }
    }
    CMASKB(pA0, pA1, 0);
    DECIDE(pA0, pA1, 0);
#pragma unroll
    for (int r = 0; r < 16; ++r) { pA0[r] = __builtin_amdgcn_exp2f(pA0[r]); pA1[r] = __builtin_amdgcn_exp2f(pA1[r]); }
    WAIT_BAR(0);
    DMA_K(3, 0); DMA_V(1, PSLOT); DMA_R(2, 2 * PSLOT);
    ROT();
    s16x8 kf[8];
    { kload2(kf, kp0 + sl_cur, 0); kload2(kf, kp0 + sl_cur, 1); kload2(kf, kp0 + sl_cur, 2); kload2(kf, kp0 + sl_cur, 3); }
    WAIT_BAR_X(2, 3);
    s16x4 vlo[8], vhi[8]; u32x4 pw0, pw1, pw2, pw3;
#define PKW(P, B) pk_h16(P[B], P[B + 1])
#define PAF(k) __builtin_bit_cast(s16x8, pw##k)
#define VFR(i) (s16x8){vlo[i][0], vlo[i][1], vlo[i][2], vlo[i][3], vhi[i][0], vhi[i][1], vhi[i][2], vhi[i][3]}
#define PIN(x) asm volatile("" : "+v"(x))
#define GAPA(MF, A0, A1, A2, A3, W0, W1, PW) do { MF; sacc += A0; sacc += A1; sacc += A2; sacc += A3; PIN(sacc); W0; W1; PIN(PW); SBAR(); } while (0)
#define EX(v) __builtin_amdgcn_exp2f(v)
#define GAPB(MF, X, B) do { MF; X[B] = EX(X[B]); X[B + 1] = EX(X[B + 1]); X[B + 2] = EX(X[B + 2]); X[B + 3] = EX(X[B + 3]); PIN(X); SBAR(); } while (0)
#define VRD(i) do { vlo[i] = vtr(vp_ + (((i) >> 2) * 4096 + ((i) & 3) * 1024)); vhi[i] = vtr(vp_ + (((i) >> 2) * 4096 + ((i) & 3) * 1024 + 512)); } while (0)
#define KRD(G, j) do { if (G) { kload2(kf, kp0 + sl_next, j); SBAR(); } } while (0)
#define STEP(C0, C1, P0, P1, t, GK, GV, GR, GL) do { SBAR(); \
    if (MOBA && (((t) & 3) == 0)) SETC(t); \
    const lds_cptr vp_ = vp0 + sl_prev; \
    s16x8 kr0_, kr1_, kr2_, kr3_; \
    if (KD == 6) { const lds_cptr krp_ = krp0 + (sl_cur >> 1); kr0_ = *(lds_k8)(krp_); kr1_ = *(lds_k8)(krp_ + 512); kr2_ = *(lds_k8)(krp_ + 2048); kr3_ = *(lds_k8)(krp_ + 2560); } \
    if (KD == 6) { C0 = mma32(kr0_, qr[KD - 2], CIN); C1 = mma32(kr1_, qr[KD - 2], CIN); C0 = mma32(kr2_, qr[KD - 1], C0); C1 = mma32(kr3_, qr[KD - 1], C1); SBAR(); } \
    VRD(0); SBAR(); float sacc = (P0[0] + P0[1]); \
    GAPA(C0 = mma32(kf[0], qr[0], KD == 6 ? C0 : CIN), P0[2], P0[3], P0[4], P0[5],     pw0[0] = PKW(P0, 0), pw0[1] = PKW(P0, 2), pw0); \
    VRD(4); SBAR(); GAPA(C1 = mma32(kf[1], qr[0], KD == 6 ? C1 : CIN), P0[6], P0[7], P0[8], P0[9],     pw0[2] = PKW(P0, 4), pw0[3] = PKW(P0, 6), pw0); \
    VRD(1); SBAR(); GAPA(C0 = mma32(kf[2], qr[1], C0),   P0[10], P0[11], P0[12], P0[13], pw1[0] = PKW(P0, 8), pw1[1] = PKW(P0, 10), pw1); \
    VRD(5); SBAR(); GAPA(C1 = mma32(kf[3], qr[1], C1),   P0[14], P0[15], P1[0], P1[1],   pw1[2] = PKW(P0, 12), pw1[3] = PKW(P0, 14), pw1); \
    VRD(2); SBAR(); GAPA(C0 = mma32(kf[4], qr[2], C0),   P1[2], P1[3], P1[4], P1[5],     pw2[0] = PKW(P1, 0), pw2[1] = PKW(P1, 2), pw2); \
    VRD(6); SBAR(); GAPA(C1 = mma32(kf[5], qr[2], C1),   P1[6], P1[7], P1[8], P1[9],     pw2[2] = PKW(P1, 4), pw2[3] = PKW(P1, 6), pw2); \
    VRD(3); SBAR(); GAPA(C0 = mma32(kf[6], qr[3], C0),   P1[10], P1[11], P1[12], P1[13], pw3[0] = PKW(P1, 8), pw3[1] = PKW(P1, 10), pw3); \
    VRD(7); SBAR(); GAPA(C1 = mma32(kf[7], qr[3], C1),   P1[14], P1[15], 0.f, 0.f,       pw3[2] = PKW(P1, 12), pw3[3] = PKW(P1, 14), pw3); \
    l_reg += sacc; \
    if (GK) { DMA_K((t) + 3, sl_cur); } if (GV) { DMA_V((t) + 1, sl_next); } if (KD == 6) { if (GR) { DMA_R((t) + 2, sl_prev); } } \
    CMASK(C0, C1, t); \
    DECIDE(C0, C1, t); \
    SBAR(); \
    GAPB(o[0] = mma32(PAF(0), VFR(0), o[0]), C0, 0); \
    GAPB(o[1] = mma32(PAF(0), VFR(4), o[1]), C0, 4); \
    KRD(GL, 0); GAPB(o[0] = mma32(PAF(1), VFR(1), o[0]), C0, 8); \
    KRD(GL, 1); GAPB(o[1] = mma32(PAF(1), VFR(5), o[1]), C0, 12); \
    KRD(GL, 2); GAPB(o[0] = mma32(PAF(2), VFR(2), o[0]), C1, 0); \
    KRD(GL, 3); GAPB(o[1] = mma32(PAF(2), VFR(6), o[1]), C1, 4); \
    GAPB(o[0] = mma32(PAF(3), VFR(3), o[0]), C1, 8); \
    GAPB(o[1] = mma32(PAF(3), VFR(7), o[1]), C1, 12); \
    } while (0)
    int t = 1;
#define CMASK(P0, P1, t) do {} while (0)
    for (; t + 5 < NT; t += 2) {
        STEP(pB0, pB1, pA0, pA1, t, true, true, true, true);         WAIT_BAR_X(2, 3); RESC(); ROT();
        STEP(pA0, pA1, pB0, pB1, t + 1, true, true, true, true);     WAIT_BAR_X(2, 3); RESC(); ROT();
    }
#undef CMASK
#define CMASK(P0, P1, t) CMASKB(P0, P1, t)
#define ENDW(tt) do { if ((tt) + 3 < NT) { WAIT_BAR_X(2, 3); } else if ((tt) + 2 < NT) { WAIT_BAR_X(1, 2); } else { WAIT_BAR(0); } } while (0)
    for (; t + 1 < NT; t += 2) {
        STEP(pB0, pB1, pA0, pA1, t, (t + 3 < NT), (t + 1 < NT), (t + 2 < NT), (t + 1 < NT));         ENDW(t);     RESC(); ROT();
        STEP(pA0, pA1, pB0, pB1, t + 1, (t + 4 < NT), (t + 2 < NT), (t + 3 < NT), (t + 2 < NT));     ENDW(t + 1); RESC(); ROT();
    }
    STEP(pB0, pB1, pA0, pA1, NT - 1, false, false, false, false); RESC();
    { float sacc = pB0[0] + pB0[1];
#pragma unroll
      for (int r = 2; r < 16; ++r) sacc += pB0[r];
#pragma unroll
      for (int r = 0; r < 16; ++r) sacc += pB1[r];
      l_reg += sacc;
      pw0 = (u32x4){PKW(pB0, 0), PKW(pB0, 2), PKW(pB0, 4), PKW(pB0, 6)}; pw1 = (u32x4){PKW(pB0, 8), PKW(pB0, 10), PKW(pB0, 12), PKW(pB0, 14)};
      pw2 = (u32x4){PKW(pB1, 0), PKW(pB1, 2), PKW(pB1, 4), PKW(pB1, 6)}; pw3 = (u32x4){PKW(pB1, 8), PKW(pB1, 10), PKW(pB1, 12), PKW(pB1, 14)};
      SBAR();
      const lds_cptr vp_ = vp0 + sl_cur;
#pragma unroll
      for (int i = 0; i < 8; ++i) { vlo[i] = vtr(vp_ + ((i >> 2) * 4096 + (i & 3) * 1024)); vhi[i] = vtr(vp_ + ((i >> 2) * 4096 + (i & 3) * 1024 + 512)); }
      o[0] = mma32(PAF(0), VFR(0), o[0]); o[0] = mma32(PAF(1), VFR(1), o[0]); o[0] = mma32(PAF(2), VFR(2), o[0]); o[0] = mma32(PAF(3), VFR(3), o[0]);
      o[1] = mma32(PAF(0), VFR(4), o[1]); o[1] = mma32(PAF(1), VFR(5), o[1]); o[1] = mma32(PAF(2), VFR(6), o[1]); o[1] = mma32(PAF(3), VFR(7), o[1]); }
    l_reg = xhalf_sum(l_reg);
    if (hi == 0) wsf[32 + r32] = l_reg;
    asm volatile("s_waitcnt lgkmcnt(0)" ::: "memory");
    h16* Ow = T.MIX + (rowbase + q0 + wid * QBLK) * 1024 + (MOBA ? 512 : 0) + h * 64;
    { __attribute__((address_space(3))) h16* stg = (__attribute__((address_space(3))) h16*)(shm + P_OST) + wid * 2048;
#pragma unroll
        for (int r = 0; r < 16; ++r) { const int orow = crow(r, hi); const float rl = __builtin_amdgcn_rcpf(wsf[32 + orow]);
#pragma unroll
            for (int d0 = 0; d0 < 2; ++d0) stg[orow * 64 + d0 * 32 + r32] = (h16)(o[d0][r] * rl); }
        asm volatile("s_waitcnt lgkmcnt(0)" ::: "memory");
#pragma unroll
        for (int i = 0; i < 4; ++i) { const int row = i * 8 + (lane >> 3), ch = lane & 7; const u32x4 v = *(const __attribute__((address_space(3))) u32x4*)(stg + row * 64 + ch * 8); *(u32x4*)(Ow + (size_t)row * 1024 + ch * 8) = v; } }
    asm volatile("s_waitcnt lgkmcnt(0)\n\ts_barrier" ::: "memory");
#undef DMA_K
#undef DMA_V
#undef DMA_R
#undef WAIT_BAR_X
#undef SETC
#undef CIN
#undef CMASKB
#undef CMASK
#undef DECIDE
#undef RESC
#undef ROT
#undef PKW
#undef PAF
#undef VFR
#undef PIN
#undef GAPA
#undef EX
#undef GAPB
#undef VRD
#undef KRD
#undef STEP
#undef ENDW
}
#ifndef ATT_PIPE
#define ATT_PIPE 3
#endif
__device__ __forceinline__ void attn_phase2(int vcu, const Tensors& T, lds_ptr shm) {
    const int bh = vcu >> 2, sub = vcu & 3, b = bh >> 3, h = bh & 7;
    for (int i = 0; i < 4; ++i) { const int s = 2 * sub + (i >> 1), qb = (i & 1) ? 15 - s : s; if (ATT_PIPE & 2) attn_unit_p<6, false>(b, h, qb, T, shm); else attn_unit<6, false>(b, h, qb, T, shm); }
    for (int i = 0; i < 4; ++i) { const int s = 2 * sub + (i >> 1), qb = (i & 1) ? 15 - s : s; if (ATT_PIPE & 1) attn_unit_p<4, true>(b, h, qb, T, shm); else attn_unit<4, true>(b, h, qb, T, shm); }
}
#undef SBAR
#undef WAIT_BAR
}


constexpr int NWAVES = 8;
constexpr int RING_OFF = 0, RING_BYTES = 131072;
constexpr int LDSCTL_OFF = RING_BYTES, MISC_OFF = LDSCTL_OFF + 320;
constexpr int LDS_BYTES = 147456;
#ifndef MK_N_LAUNCHES
#define MK_N_LAUNCHES 1
#endif

struct Frame {
    LAS unsigned char* lds;
    volatile LAS unsigned* MISC;
    gu32* ctl;
    int tid, lane, wave;
    int vcu, G;
};
struct Args {
    const float* in[13]; float* out; unsigned char* ws; int ph_lo, ph_hi;
};

template <int MODE  , bool F16>
__device__ __forceinline__ void p0_transpose_item(const float* W, int K, int N, const float* gk, u16* WT, LAS float* scr, int item, int NP, int lane) {
    const int nblk = NP / 32, kb = item / nblk, nb = item % nblk, k0 = 64 * kb, n0 = 32 * nb;
    const int p = n0 + (lane & 31);
    const int src = MODE == 0 ? src_col_in(p) : MODE == 1 ? src_col_qu(p) : MODE == 2 ? src_col_kvu(p) : p;
#pragma unroll 8
    for (int i = 0; i < 32; ++i) { const int kk = 2 * i + (lane >> 5); float v = src >= 0 ? W[(size_t)(k0 + kk) * N + src] : 0.f; if (gk) v *= gk[k0 + kk]; scr[kk * 33 + (lane & 31)] = v; }
    LDS_WAIT(); asm volatile("" ::: "memory");
    const int c = lane & 7;
#pragma unroll
    for (int j = 0; j < 4; ++j) { const int n = (lane >> 3) + 8 * j; const LAS float* s = scr + (8 * c) * 33 + n;
        v4u o;
        if (F16) { o.x = pk_h16(s[0 * 33], s[1 * 33]); o.y = pk_h16(s[2 * 33], s[3 * 33]); o.z = pk_h16(s[4 * 33], s[5 * 33]); o.w = pk_h16(s[6 * 33], s[7 * 33]); }
        else { o.x = f2bf(s[0 * 33]) | (f2bf(s[1 * 33]) << 16); o.y = f2bf(s[2 * 33]) | (f2bf(s[3 * 33]) << 16); o.z = f2bf(s[4 * 33]) | (f2bf(s[5 * 33]) << 16); o.w = f2bf(s[6 * 33]) | (f2bf(s[7 * 33]) << 16); }
        *(GAS v4u*)(WT + (size_t)(n0 + n) * K + k0 + 8 * c) = o; }
    LDS_WAIT(); asm volatile("" ::: "memory");
}
__device__ __forceinline__ void rms_row_to_h16(int lane, const float* xrow, const float* g, h16* orow) {
    const GAS f32x4* xr = (const GAS f32x4*)xrow + lane;
    f32x4 v[4]; float s = 0.f;
#pragma unroll
    for (int j = 0; j < 4; ++j) { v[j] = xr[64 * j]; s += (v[j].x * v[j].x + v[j].y * v[j].y) + (v[j].z * v[j].z + v[j].w * v[j].w); }
    const float rstd = 1.f / sqrtf(wave_sum(s) * (1.f / DM) + EPS);
    GAS unsigned long long* o8 = (GAS unsigned long long*)orow + lane;
#pragma unroll
    for (int j = 0; j < 4; ++j) { const f32x4 gg = ((const GAS f32x4*)g)[lane + 64 * j];
        o8[64 * j] = (unsigned long long)pk_h16(v[j].x * rstd * gg.x, v[j].y * rstd * gg.y) | ((unsigned long long)pk_h16(v[j].z * rstd * gg.z, v[j].w * rstd * gg.w) << 32); }
}
__device__ __forceinline__ void post4_row(int lane, const float* trow, const float* xrow, const float* g1, const float* g2, float* hrow, u16* xrow2) {
    f32x4 v[4], h[4]; float s = 0.f;
#pragma unroll
    for (int j = 0; j < 4; ++j) { v[j] = ((const GAS f32x4*)trow)[lane + 64 * j]; s += (v[j].x * v[j].x + v[j].y * v[j].y) + (v[j].z * v[j].z + v[j].w * v[j].w); }
    const float rstd = 1.f / sqrtf(wave_sum(s) * (1.f / DM) + EPS); float s2 = 0.f;
#pragma unroll
    for (int j = 0; j < 4; ++j) { const f32x4 xx = ((const GAS f32x4*)xrow)[lane + 64 * j], ga = ((const GAS f32x4*)g1)[lane + 64 * j];
        h[j] = xx + v[j] * rstd * ga; ((GAS f32x4*)hrow)[lane + 64 * j] = h[j]; s2 += (h[j].x * h[j].x + h[j].y * h[j].y) + (h[j].z * h[j].z + h[j].w * h[j].w); }
    const float r2 = 1.f / sqrtf(wave_sum(s2) * (1.f / DM) + EPS);
    GAS unsigned long long* o8 = (GAS unsigned long long*)xrow2 + lane;
#pragma unroll
    for (int j = 0; j < 4; ++j) { const f32x4 gb = ((const GAS f32x4*)g2)[lane + 64 * j];
        o8[64 * j] = (unsigned long long)(f2bf(h[j].x * r2 * gb.x) | (f2bf(h[j].y * r2 * gb.y) << 16)) | ((unsigned long long)(f2bf(h[j].z * r2 * gb.z) | (f2bf(h[j].w * r2 * gb.w) << 16)) << 32); }
}
__device__ __forceinline__ void post6_row(int lane, const float* trow, const float* g, float* orow) {
    f32x4 v[4]; float s = 0.f;
#pragma unroll
    for (int j = 0; j < 4; ++j) { v[j] = ((const GAS f32x4*)trow)[lane + 64 * j]; s += (v[j].x * v[j].x + v[j].y * v[j].y) + (v[j].z * v[j].z + v[j].w * v[j].w); }
    const float rstd = 1.f / sqrtf(wave_sum(s) * (1.f / DM) + EPS);
#pragma unroll
    for (int j = 0; j < 4; ++j) { const f32x4 gg = ((const GAS f32x4*)g)[lane + 64 * j]; GAS f32x4* o = (GAS f32x4*)orow + lane + 64 * j; *o = *o + v[j] * rstd * gg; }
}

constexpr int N_PHASES = 9;
#ifndef REPEAT_PH
#define REPEAT_PH -1
#endif
__global__ void __launch_bounds__(NWAVES * 64, 2) mk_fwd(Args args) {
    extern __shared__ __attribute__((aligned(16))) unsigned char lds[];
    Frame F;
    F.lds = (LAS unsigned char*)lds;
    F.MISC = (volatile LAS unsigned*)(F.lds + MISC_OFF);
    F.tid = threadIdx.x; F.lane = F.tid & 63; F.wave = __builtin_amdgcn_readfirstlane(F.tid >> 6);
    F.G = gridDim.x; { const int bx = blockIdx.x; F.vcu = (F.G % 8 == 0) ? (bx % 8) * (F.G / 8) + bx / 8 : bx; }
    unsigned char* ws = args.ws;
    F.ctl = (gu32*)(ws + WS_CTL);
    const float* x = args.in[0]; const float* g_pre = args.in[1]; const float* w_in = args.in[2];
    const float* g_q = args.in[3]; const float* w_qup = args.in[4]; const float* g_kv = args.in[5]; const float* w_kvup = args.in[6];
    const float* w_out = args.in[7]; const float* g_post = args.in[8]; const float* g_pre2 = args.in[9];
    const float* w_up = args.in[10]; const float* w_down = args.in[11]; const float* g_post2 = args.in[12];
    float* out = args.out;
    u16* WIN = (u16*)(ws + WS_WIN); u16* WQU = (u16*)(ws + WS_WQU); u16* WKVU = (u16*)(ws + WS_WKVU); u16* WOUT = (u16*)(ws + WS_WOUT); u16* WUP = (u16*)(ws + WS_WUP); u16* WDN = (u16*)(ws + WS_WDN);
    float2* ropem = (float2*)(ws + WS_ROPE_M); float2* ropea = (float2*)(ws + WS_ROPE_A);
    float* kmean = (float*)(ws + WS_KMEAN); float* rsq_q = (float*)(ws + WS_RSQ); float* rsq_kv = rsq_q + (size_t)M * 4;
    h16* XN = (h16*)(ws + WS_XN); h16* QM = (h16*)(ws + WS_QM); h16* KM = (h16*)(ws + WS_KM); h16* VM = (h16*)(ws + WS_VM);
    h16* CQ = (h16*)(ws + WS_CQ); h16* CKV = (h16*)(ws + WS_CKV); h16* KR = (h16*)(ws + WS_KR);
    h16* QN = (h16*)(ws + WS_QN); h16* QR = (h16*)(ws + WS_QR); h16* KN = (h16*)(ws + WS_KN); h16* VA = (h16*)(ws + WS_VA); h16* MIX = (h16*)(ws + WS_MIX);
    u16* A2 = (u16*)(ws + WS_A2); float* t_out = (float*)(ws + WS_T_OUT); float* t_dn = (float*)(ws + WS_T_DN);

    for (int u = F.tid; u < (LDS_BYTES - LDSCTL_OFF) / 4; u += NWAVES * 64) ((LAS unsigned*)(F.lds + LDSCTL_OFF))[u] = 0u;
    __syncthreads();
    XcdBarrier bar; bar.bar = (unsigned*)(F.ctl + CW_BAR); bar.x = 0; bar.st = nullptr;
    if (MK_N_LAUNCHES == 1) bar = xcd_barrier_post((unsigned*)(F.ctl + CW_BAR), F.MISC + 8);
#define GRID_BAR() do { if (MK_N_LAUNCHES == 1) xcd_barrier(bar); } while (0)
    const int lo = args.ph_lo, hi = args.ph_hi;
#define IN(k) (lo <= (k) && (k) < hi)
#define BOTH(k) (IN(k) && IN((k) + 1))
    int gw, NGW = F.G * NWAVES;
#define FRESH() do { int t_ = threadIdx.x; asm volatile("" : "+v"(t_)); F.tid = t_; F.lane = t_ & 63; F.wave = __builtin_amdgcn_readfirstlane(t_ >> 6); gw = F.vcu * NWAVES + F.wave; } while (0)

    if (IN(0)) { FRESH();
        LAS float* scr = (LAS float*)(F.lds + RING_OFF + F.wave * 16384);
        constexpr int I_IN = (DM / 64) * (NINP / 32), I_QU = (256 / 64) * (768 / 32), I_KVU = (128 / 64) * (1024 / 32), I_OUT = (DM / 64) * (DM / 32), I_UP = (DM / 64) * (FF / 32), I_DN = (FF / 64) * (DM / 32);
        constexpr int NITEMS = I_IN + I_QU + I_KVU + I_OUT + I_UP + I_DN;
        for (int it = gw; it < NITEMS; it += NGW) {
            int r = it;
            if (r < I_IN) { p0_transpose_item<0, true>(w_in, DM, NIN, nullptr, WIN, scr, r, NINP, F.lane); continue; } r -= I_IN;
            if (r < I_QU) { p0_transpose_item<1, true>(w_qup, 256, 768, g_q, WQU, scr, r, 768, F.lane); continue; } r -= I_QU;
            if (r < I_KVU) { p0_transpose_item<2, true>(w_kvup, 128, 1024, g_kv, WKVU, scr, r, 1024, F.lane); continue; } r -= I_KVU;
            if (r < I_OUT) { p0_transpose_item<3, true>(w_out, DM, DM, nullptr, WOUT, scr, r, DM, F.lane); continue; } r -= I_OUT;
            if (r < I_UP) { p0_transpose_item<3, false>(w_up, DM, FF, nullptr, WUP, scr, r, FF, F.lane); continue; } r -= I_UP;
            p0_transpose_item<3, false>(w_down, FF, DM, nullptr, WDN, scr, r, DM, F.lane);
        }
        for (int i = blockIdx.x * (NWAVES * 64) + F.tid; i < SEQ * 32; i += F.G * NWAVES * 64) {
            { const int pos = i / 32, f = i % 32; const float inv = 1.0f / powf(10000.0f, (float)f / 32.0f); const float ang = (float)pos * inv; ropem[i] = make_float2((float)cos((double)ang), (float)sin((double)ang)); }
            if (i < SEQ * 16) { const int pos = i / 16, f = i % 16; const float inv = 1.0f / powf(10000.0f, (float)f / 16.0f); const float ang = (float)pos * inv; ropea[i] = make_float2((float)cos((double)ang), (float)sin((double)ang)); }
        }
        for (int m = gw; m < M; m += NGW) rms_row_to_h16(F.lane, x + (size_t)m * DM, g_pre, XN + (size_t)m * DM);
        if (BOTH(0)) GRID_BAR();
    }
    if (IN(1)) {
        pg8::Gemm g{(const u16*)XN, WIN, M, NINP, DM}; pg8::StaticOrder S; S.init(M, NINP, F.G, (int)blockIdx.x);
        pg8::EpiP1 E{QM, KM, VM, CQ, CKV, KR, kmean, rsq_q, rsq_kv, ropem, ropea};
        pg8::gemm_phase<true, pg8::EpiP1, pg8::StaticOrder, true, true>(F.lds + RING_OFF, g, S, E);
        if (BOTH(1)) GRID_BAR();
    }
    if (IN(2)) {
        { pg8::Gemm g{(const u16*)CQ, WQU, M, 768, 256}; pg8::StaticOrder S; S.init(M, 768, F.G, (int)blockIdx.x);
          pg8::EpiQU E{QN, QR, rsq_q, ropea};
          pg8::gemm_phase<true, pg8::EpiQU, pg8::StaticOrder, true, true>(F.lds + RING_OFF, g, S, E); }
        { pg8::Gemm g{(const u16*)CKV, WKVU, M, 1024, 128}; pg8::StaticOrder S; S.init(M, 1024, F.G, (int)blockIdx.x);
          pg8::EpiKVU E{KN, VA, rsq_kv};
          pg8::gemm_phase<true, pg8::EpiKVU, pg8::StaticOrder, true, true>(F.lds + RING_OFF, g, S, E); }
        if (BOTH(2)) GRID_BAR();
    }
    if (IN(3)) {
        if (F.G == 256) { const att::Tensors T{QN, QR, KN, KR, VA, QM, KM, VM, kmean, MIX}; att::attn_phase2(F.vcu, T, F.lds + RING_OFF); }
        if (REPEAT_PH == 3) { GRID_BAR(); const att::Tensors T{QN, QR, KN, KR, VA, QM, KM, VM, kmean, MIX}; att::attn_phase2(F.vcu, T, F.lds + RING_OFF); }
        if (BOTH(3)) GRID_BAR();
    }
    if (IN(4)) {
        pg8::Gemm g{(const u16*)MIX, WOUT, M, DM, DM}; pg8::StaticOrder S; S.init(M, DM, F.G, (int)blockIdx.x);
        pg8::EpiF32 E{t_out, DM};
        pg8::gemm_phase<true, pg8::EpiF32, pg8::StaticOrder, true, true>(F.lds + RING_OFF, g, S, E);
        if (BOTH(4)) GRID_BAR();
    }
    if (IN(5)) { FRESH();
        for (int m = gw; m < M; m += NGW) post4_row(F.lane, t_out + (size_t)m * DM, x + (size_t)m * DM, g_post, g_pre2, out + (size_t)m * DM, (u16*)XN + (size_t)m * DM);
        if (BOTH(5)) GRID_BAR();
    }
    if (IN(6)) {
        pg8::Gemm g{(const u16*)XN, WUP, M, FF, DM}; pg8::StaticOrder S; S.init(M, FF, F.G, (int)blockIdx.x);
        pg8::EpiRelu2 E{A2, FF};
        pg8::gemm_phase<false, pg8::EpiRelu2, pg8::StaticOrder, true, true>(F.lds + RING_OFF, g, S, E);
        if (BOTH(6)) GRID_BAR();
    }
    if (IN(7)) {
        pg8::Gemm g{(const u16*)A2, WDN, M, DM, FF}; pg8::StaticOrder S; S.init(M, DM, F.G, (int)blockIdx.x);
        pg8::EpiF32 E{t_dn, DM};
        pg8::gemm_phase<false, pg8::EpiF32, pg8::StaticOrder, true, true>(F.lds + RING_OFF, g, S, E);
        if (BOTH(7)) GRID_BAR();
    }
    if (IN(8)) { FRESH();
        for (int m = gw; m < M; m += NGW) post6_row(F.lane, t_dn + (size_t)m * DM, g_post2, out + (size_t)m * DM);
    }
#undef IN
#undef BOTH
}

__global__ void k_rope_tables(float2* tm, float2* ta) {
    const int i = blockIdx.x * blockDim.x + threadIdx.x;
    if (i < SEQ * 32) { const int pos = i / 32, f = i % 32; const float inv = 1.0f / powf(10000.0f, (float)f / 32.0f); const float ang = (float)pos * inv;
        tm[i] = make_float2((float)cos((double)ang), (float)sin((double)ang)); }
    if (i < SEQ * 16) { const int pos = i / 16, f = i % 16; const float inv = 1.0f / powf(10000.0f, (float)f / 16.0f); const float ang = (float)pos * inv;
        ta[i] = make_float2((float)cos((double)ang), (float)sin((double)ang)); }
}

__global__ void k_rmsnorm_f16(const float* x, const float* g, h16* xn) {
    const int lane = threadIdx.x & 63, row = blockIdx.x * 4 + (threadIdx.x >> 6);
    const float4* xr = (const float4*)(x + (size_t)row * DM) + lane;
    float4 v[4]; float s = 0.f;
#pragma unroll
    for (int j = 0; j < 4; ++j) { v[j] = xr[64 * j]; s += (v[j].x * v[j].x + v[j].y * v[j].y) + (v[j].z * v[j].z + v[j].w * v[j].w); }
    const float rstd = 1.0f / sqrtf(wave_sum(s) * (1.f / DM) + EPS);
#pragma unroll
    for (int j = 0; j < 4; ++j) { const float4 gg = ((const float4*)g)[lane + 64 * j]; h16* o = xn + (size_t)row * DM + 4 * (lane + 64 * j);
        o[0] = (h16)(v[j].x * rstd * gg.x); o[1] = (h16)(v[j].y * rstd * gg.y); o[2] = (h16)(v[j].z * rstd * gg.z); o[3] = (h16)(v[j].w * rstd * gg.w); }
}

template <int AT, int EPI>
__global__ void __launch_bounds__(256) k_naive_gemm(const u16* A, int lda, const float* W, int K, int N, float* C32, u16* C16, int ldc) {
    __shared__ __attribute__((aligned(16))) float As[16][260];
    const int t = threadIdx.x, col = blockIdx.x * 256 + t, r0 = blockIdx.y * 16;
    float acc[16];
#pragma unroll
    for (int r = 0; r < 16; ++r) acc[r] = 0.f;
    for (int kc = 0; kc < K; kc += 256) {
        __syncthreads();
#pragma unroll
        for (int i = 0; i < 16; ++i) { const u16 a = A[(size_t)(r0 + i) * lda + kc + t]; As[i][t] = AT == 0 ? (float)__builtin_bit_cast(h16, a) : bf2f(a); }
        __syncthreads();
        if (col < N) {
            for (int k = 0; k < 256; k += 4) {
                const float w0 = W[(size_t)(kc + k) * N + col], w1 = W[(size_t)(kc + k + 1) * N + col], w2 = W[(size_t)(kc + k + 2) * N + col], w3 = W[(size_t)(kc + k + 3) * N + col];
#pragma unroll
                for (int r = 0; r < 16; ++r) { const float4 a = *(const float4*)&As[r][k]; acc[r] += (a.x * w0 + a.y * w1) + (a.z * w2 + a.w * w3); }
            }
        }
    }
    if (col < N) {
#pragma unroll
        for (int r = 0; r < 16; ++r) {
            if (EPI == 0) C32[(size_t)(r0 + r) * ldc + col] = acc[r];
            else { const float v = acc[r] > 0.f ? acc[r] : 0.f; C16[(size_t)(r0 + r) * ldc + col] = (u16)f2bf(v * v); }
        }
    }
}

__global__ void __launch_bounds__(256) k_post1(const float* proj, const float2* ropem, const float2* ropea, h16* CQ, h16* CKV, h16* KR, h16* QM, h16* KM, h16* VM, float* rsq_q, float* rsq_kv) {
    __shared__ float p[NIN]; __shared__ float scr[4];
    const int m = blockIdx.x, t = threadIdx.x, pos = m % SEQ;
    for (int c = t; c < NIN; c += 256) p[c] = proj[(size_t)m * NIN + c];
    __syncthreads();
    { const float v = p[C_CQ + t]; CQ[(size_t)m * 256 + t] = (h16)v; const float ss = block_sum256(v * v, scr); if (t < 4) rsq_q[(size_t)m * 4 + t] = t == 0 ? ss : 0.f; }
    { const float v = t < 128 ? p[C_CKV + t] : 0.f; if (t < 128) CKV[(size_t)m * 128 + t] = (h16)v; const float ss = block_sum256(v * v, scr); if (t < 4) rsq_kv[(size_t)m * 4 + t] = t == 0 ? ss : 0.f; }
    if (t < 16) { const float2 cs = ropea[pos * 16 + t]; const float a = p[C_KR + t], b = p[C_KR + t + 16];
        KR[(size_t)m * 32 + t] = (h16)(a * cs.x - b * cs.y); KR[(size_t)m * 32 + t + 16] = (h16)(b * cs.x + a * cs.y); }
    { const int h = t >> 5, i = t & 31; const float2 cs = ropem[pos * 32 + i];
        { const float a = p[C_MQ + h * 64 + i], b = p[C_MQ + h * 64 + i + 32];
          QM[(size_t)m * 512 + h * 64 + i] = (h16)((a * cs.x - b * cs.y) * C2M); QM[(size_t)m * 512 + h * 64 + i + 32] = (h16)((b * cs.x + a * cs.y) * C2M); }
        { const float a = p[C_MK + h * 64 + i], b = p[C_MK + h * 64 + i + 32];
          KM[(size_t)m * 512 + h * 64 + i] = (h16)(a * cs.x - b * cs.y); KM[(size_t)m * 512 + h * 64 + i + 32] = (h16)(b * cs.x + a * cs.y); } }
    VM[(size_t)m * 512 + t] = (h16)p[C_MV + t]; VM[(size_t)m * 512 + 256 + t] = (h16)p[C_MV + 256 + t];
}

__global__ void __launch_bounds__(512) k_kmean(const h16* KM, float* kmean) {
    const int bb = blockIdx.x, c = threadIdx.x; float s = 0.f;
    for (int r = 0; r < 256; ++r) s += (float)KM[((size_t)bb * 256 + r) * 512 + c];
    kmean[(size_t)bb * 512 + c] = s * (1.f / 256.f); kmean[(size_t)NB * 16 * 512 + (size_t)bb * 512 + c] = 0.f;
}

__global__ void __launch_bounds__(256) k_mla_up(const h16* CQ, const h16* CKV, const float* rsq_q, const float* rsq_kv, const float* gq, const float* Wq, const float* gkv, const float* Wkv,
                                                const float2* ropea, h16* QN, h16* QR, h16* KN, h16* VA) {
    __shared__ float cq[4][256], ckv[4][128], qo[4][768], kvo[4][1024]; __shared__ float rq[4], rkv[4];
    const int t = threadIdx.x, m0 = blockIdx.x * 4;
    for (int i = 0; i < 4; ++i) { cq[i][t] = (float)CQ[(size_t)(m0 + i) * 256 + t] * gq[t]; if (t < 128) ckv[i][t] = (float)CKV[(size_t)(m0 + i) * 128 + t] * gkv[t]; }
    if (t < 4) { const float* a = rsq_q + (size_t)(m0 + t) * 4; rq[t] = 1.0f / sqrtf(((a[0] + a[1]) + (a[2] + a[3])) * (1.f / 256.f) + EPS);
                 const float* b = rsq_kv + (size_t)(m0 + t) * 4; rkv[t] = 1.0f / sqrtf(((b[0] + b[1]) + (b[2] + b[3])) * (1.f / 128.f) + EPS); }
    __syncthreads();
    for (int j = 0; j < 3; ++j) { const int c = t + 256 * j; float a0 = 0, a1 = 0, a2 = 0, a3 = 0;
        for (int k = 0; k < 256; ++k) { const float w = Wq[(size_t)k * 768 + c]; a0 += cq[0][k] * w; a1 += cq[1][k] * w; a2 += cq[2][k] * w; a3 += cq[3][k] * w; }
        qo[0][c] = a0 * rq[0]; qo[1][c] = a1 * rq[1]; qo[2][c] = a2 * rq[2]; qo[3][c] = a3 * rq[3]; }
    for (int j = 0; j < 4; ++j) { const int c = t + 256 * j; float a0 = 0, a1 = 0, a2 = 0, a3 = 0;
        for (int k = 0; k < 128; ++k) { const float w = Wkv[(size_t)k * 1024 + c]; a0 += ckv[0][k] * w; a1 += ckv[1][k] * w; a2 += ckv[2][k] * w; a3 += ckv[3][k] * w; }
        kvo[0][c] = a0 * rkv[0]; kvo[1][c] = a1 * rkv[1]; kvo[2][c] = a2 * rkv[2]; kvo[3][c] = a3 * rkv[3]; }
    __syncthreads();
    for (int i = 0; i < 4; ++i) { const int m = m0 + i, pos = m % SEQ;
        for (int c = t; c < 512; c += 256) { const int h = c >> 6, d = c & 63;
            QN[(size_t)m * 512 + c] = (h16)(qo[i][h * 96 + d] * C2A); KN[(size_t)m * 512 + c] = (h16)kvo[i][h * 128 + d]; VA[(size_t)m * 512 + c] = (h16)kvo[i][h * 128 + 64 + d]; }
        if (t < 128) { const int h = t >> 4, f = t & 15; const float2 cs = ropea[pos * 16 + f]; const float a = qo[i][h * 96 + 64 + f], b = qo[i][h * 96 + 64 + f + 16];
            QR[(size_t)m * 256 + h * 32 + f] = (h16)((a * cs.x - b * cs.y) * C2A); QR[(size_t)m * 256 + h * 32 + f + 16] = (h16)((b * cs.x + a * cs.y) * C2A); } }
}

__global__ void __launch_bounds__(256) k_attn_mla(const h16* QN, const h16* QR, const h16* KN, const h16* KRp, const h16* VA, h16* mix) {
    __shared__ __attribute__((aligned(16))) float Ks[32][96]; __shared__ __attribute__((aligned(16))) float Vs[32][64];
    const int qb = blockIdx.x, h = blockIdx.y, b = blockIdx.z, t = threadIdx.x;
    const int qpos = qb * 256 + t; const size_t m = (size_t)b * SEQ + qpos;
    float q[96], o[64];
#pragma unroll
    for (int d = 0; d < 64; ++d) { q[d] = (float)QN[m * 512 + h * 64 + d]; o[d] = 0.f; }
#pragma unroll
    for (int d = 0; d < 32; ++d) q[64 + d] = (float)QR[m * 256 + h * 32 + d];
    float mx = -INFINITY, l = 0.f;
    for (int t0 = 0; t0 < qb * 256 + 256; t0 += 32) {
        __syncthreads();
        for (int e = t; e < 32 * 96; e += 256) { const int j = e / 96, d = e % 96; const size_t km = (size_t)b * SEQ + t0 + j;
            Ks[j][d] = d < 64 ? (float)KN[km * 512 + h * 64 + d] : (float)KRp[km * 32 + d - 64]; }
        for (int e = t; e < 32 * 64; e += 256) { const int j = e >> 6, d = e & 63; Vs[j][d] = (float)VA[((size_t)b * SEQ + t0 + j) * 512 + h * 64 + d]; }
        __syncthreads();
        float s[32]; float mt = -INFINITY;
#pragma unroll
        for (int j = 0; j < 32; ++j) { float a = 0.f;
#pragma unroll
            for (int d = 0; d < 96; d += 4) { const float4 kk = *(const float4*)&Ks[j][d]; a += (q[d] * kk.x + q[d + 1] * kk.y) + (q[d + 2] * kk.z + q[d + 3] * kk.w); }
            s[j] = (t0 + j <= qpos) ? a : -INFINITY; mt = fmaxf(mt, s[j]); }
        const float mn = fmaxf(mx, mt);
        if (mn == -INFINITY) continue;
        const float alpha = exp2f(mx - mn); mx = mn; l *= alpha;
#pragma unroll
        for (int d = 0; d < 64; ++d) o[d] *= alpha;
#pragma unroll
        for (int j = 0; j < 32; ++j) { const float pj = exp2f(s[j] - mn); l += pj;
#pragma unroll
            for (int d = 0; d < 64; d += 4) { const float4 vv = *(const float4*)&Vs[j][d]; o[d] += pj * vv.x; o[d + 1] += pj * vv.y; o[d + 2] += pj * vv.z; o[d + 3] += pj * vv.w; } }
    }
    const float rl = 1.0f / l;
#pragma unroll
    for (int d = 0; d < 64; ++d) mix[m * 1024 + h * 64 + d] = (h16)(o[d] * rl);
}

__global__ void __launch_bounds__(256) k_attn_moba(const h16* QM, const h16* KM, const h16* VM, const float* kmean, h16* mix) {
    __shared__ __attribute__((aligned(16))) float Ks[32][64]; __shared__ __attribute__((aligned(16))) float Vs[32][64]; __shared__ float km[16][64];
    const int cur = blockIdx.x, h = blockIdx.y, b = blockIdx.z, t = threadIdx.x;
    const int qpos = cur * 256 + t; const size_t m = (size_t)b * SEQ + qpos;
    for (int e = t; e < 16 * 64; e += 256) { const int n = e >> 6, d = e & 63; const size_t idx = ((size_t)b * 16 + n) * 512 + h * 64 + d; km[n][d] = kmean[idx] + kmean[(size_t)NB * 16 * 512 + idx]; }
    float q[64], o[64];
#pragma unroll
    for (int d = 0; d < 64; ++d) { q[d] = (float)QM[m * 512 + h * 64 + d]; o[d] = 0.f; }
    __syncthreads();
    unsigned sel = 0u;
    if (cur <= 3) sel = (1u << cur) - 1u;
    else {
        float g[16];
#pragma unroll
        for (int n = 0; n < 16; ++n) { float a = 0.f;
#pragma unroll
            for (int d = 0; d < 64; ++d) a += q[d] * km[n][d];
            g[n] = n < cur ? a : -INFINITY; }
        for (int k = 0; k < 3; ++k) { float best = -INFINITY; int bi = 0;
#pragma unroll
            for (int n = 0; n < 16; ++n) if (!((sel >> n) & 1u) && g[n] > best) { best = g[n]; bi = n; }
            sel |= 1u << bi; }
    }
    float mx = -INFINITY, l = 0.f;
    for (int t0 = 0; t0 < cur * 256 + 256; t0 += 32) {
        const int n = t0 >> 8;
        __syncthreads();
        for (int e = t; e < 32 * 64; e += 256) { const int j = e >> 6, d = e & 63; const size_t km_ = ((size_t)b * SEQ + t0 + j) * 512 + h * 64 + d; Ks[j][d] = (float)KM[km_]; Vs[j][d] = (float)VM[km_]; }
        __syncthreads();
        const bool blk_ok = (n == cur) || ((sel >> n) & 1u);
        float s[32]; float mt = -INFINITY;
#pragma unroll
        for (int j = 0; j < 32; ++j) { float a = 0.f;
#pragma unroll
            for (int d = 0; d < 64; d += 4) { const float4 kk = *(const float4*)&Ks[j][d]; a += (q[d] * kk.x + q[d + 1] * kk.y) + (q[d + 2] * kk.z + q[d + 3] * kk.w); }
            s[j] = (blk_ok && (t0 + j <= qpos)) ? a : -INFINITY; mt = fmaxf(mt, s[j]); }
        const float mn = fmaxf(mx, mt);
        if (mn == -INFINITY) continue;
        const float alpha = exp2f(mx - mn); mx = mn; l *= alpha;
#pragma unroll
        for (int d = 0; d < 64; ++d) o[d] *= alpha;
#pragma unroll
        for (int j = 0; j < 32; ++j) { const float pj = exp2f(s[j] - mn); l += pj;
#pragma unroll
            for (int d = 0; d < 64; d += 4) { const float4 vv = *(const float4*)&Vs[j][d]; o[d] += pj * vv.x; o[d + 1] += pj * vv.y; o[d + 2] += pj * vv.z; o[d + 3] += pj * vv.w; } }
    }
    const float rl = 1.0f / l;
#pragma unroll
    for (int d = 0; d < 64; ++d) mix[m * 1024 + 512 + h * 64 + d] = (h16)(o[d] * rl);
}

__global__ void __launch_bounds__(256) k_post4(const float* tmp, const float* x, const float* g1, const float* g2, float* hout, u16* xn2) {
    __shared__ float scr[4];
    const int m = blockIdx.x, t = threadIdx.x;
    const float4 v = ((const float4*)(tmp + (size_t)m * DM))[t];
    const float ss = block_sum256((v.x * v.x + v.y * v.y) + (v.z * v.z + v.w * v.w), scr);
    const float rstd = 1.0f / sqrtf(ss * (1.f / DM) + EPS);
    const float4 xx = ((const float4*)(x + (size_t)m * DM))[t], ga = ((const float4*)g1)[t], gb = ((const float4*)g2)[t];
    float4 hh; hh.x = xx.x + v.x * rstd * ga.x; hh.y = xx.y + v.y * rstd * ga.y; hh.z = xx.z + v.z * rstd * ga.z; hh.w = xx.w + v.w * rstd * ga.w;
    ((float4*)(hout + (size_t)m * DM))[t] = hh;
    const float ss2 = block_sum256((hh.x * hh.x + hh.y * hh.y) + (hh.z * hh.z + hh.w * hh.w), scr);
    const float r2 = 1.0f / sqrtf(ss2 * (1.f / DM) + EPS);
    u16* o = xn2 + (size_t)m * DM + 4 * t;
    o[0] = (u16)f2bf(hh.x * r2 * gb.x); o[1] = (u16)f2bf(hh.y * r2 * gb.y); o[2] = (u16)f2bf(hh.z * r2 * gb.z); o[3] = (u16)f2bf(hh.w * r2 * gb.w);
}
__global__ void __launch_bounds__(256) k_post6(const float* tmp, const float* g, float* out) {
    __shared__ float scr[4];
    const int m = blockIdx.x, t = threadIdx.x;
    const float4 v = ((const float4*)(tmp + (size_t)m * DM))[t];
    const float ss = block_sum256((v.x * v.x + v.y * v.y) + (v.z * v.z + v.w * v.w), scr);
    const float rstd = 1.0f / sqrtf(ss * (1.f / DM) + EPS);
    const float4 gg = ((const float4*)g)[t]; float4 hh = ((float4*)(out + (size_t)m * DM))[t];
    hh.x += v.x * rstd * gg.x; hh.y += v.y * rstd * gg.y; hh.z += v.z * rstd * gg.z; hh.w += v.w * rstd * gg.w;
    ((float4*)(out + (size_t)m * DM))[t] = hh;
}


#ifndef HY
#define HY 0x7f
#endif
constexpr size_t WS_T_PROJ = 256 * MiB;
static void launch_mk(Args a, int lo, int hi, int grid, hipStream_t stream) {
    a.ph_lo = lo; a.ph_hi = hi;
    hipLaunchKernelGGL(mk_fwd, dim3(grid), dim3(NWAVES * 64), LDS_BYTES, stream, a);
}
extern "C" void kernel_launch(void* const* d_in, const int* in_sizes, int n_in, void* d_out, int out_size, void* d_ws, size_t ws_size, hipStream_t stream) {
    static int grid = 0;
    if (grid == 0) {
        if (n_in != 13 || in_sizes[0] != M * DM || out_size != M * DM || ws_size < 500 * MiB) { fprintf(stderr, "kernel_launch: unexpected shapes (n_in %d, ws %zu)\n", n_in, ws_size); grid = -1; return; }
        int dev = 0, cus = 0;
        if (hipGetDevice(&dev) != hipSuccess || hipDeviceGetAttribute(&cus, hipDeviceAttributeMultiprocessorCount, dev) != hipSuccess) { grid = -1; return; }
        if (hipFuncSetAttribute((const void*)mk_fwd, hipFuncAttributeMaxDynamicSharedMemorySize, LDS_BYTES) != hipSuccess) { fprintf(stderr, "kernel_launch: hipFuncSetAttribute failed\n"); grid = -1; return; }
        grid = cus;
    }
    if (grid < 0) return;
    const float* x = (const float*)d_in[0]; const float* g_pre = (const float*)d_in[1]; const float* w_in = (const float*)d_in[2];
    const float* g_q = (const float*)d_in[3]; const float* w_qup = (const float*)d_in[4]; const float* g_kv = (const float*)d_in[5]; const float* w_kvup = (const float*)d_in[6];
    const float* w_out = (const float*)d_in[7]; const float* g_post = (const float*)d_in[8]; const float* g_pre2 = (const float*)d_in[9];
    const float* w_up = (const float*)d_in[10]; const float* w_down = (const float*)d_in[11]; const float* g_post2 = (const float*)d_in[12];
    unsigned char* ws = (unsigned char*)d_ws; float* out = (float*)d_out;
    float2* ropem = (float2*)(ws + WS_ROPE_M); float2* ropea = (float2*)(ws + WS_ROPE_A);
    float* kmean = (float*)(ws + WS_KMEAN); float* rsq_q = (float*)(ws + WS_RSQ); float* rsq_kv = rsq_q + (size_t)M * 4;
    h16* XN = (h16*)(ws + WS_XN); h16* QM = (h16*)(ws + WS_QM); h16* KM = (h16*)(ws + WS_KM); h16* VM = (h16*)(ws + WS_VM);
    h16* CQ = (h16*)(ws + WS_CQ); h16* CKV = (h16*)(ws + WS_CKV); h16* KR = (h16*)(ws + WS_KR);
    h16* QN = (h16*)(ws + WS_QN); h16* QR = (h16*)(ws + WS_QR); h16* KN = (h16*)(ws + WS_KN); h16* VA = (h16*)(ws + WS_VA); h16* MIX = (h16*)(ws + WS_MIX);
    u16* A2 = (u16*)(ws + WS_A2);
    float* t_proj = (float*)(ws + WS_T_PROJ); float* t_out = (float*)(ws + WS_T_OUT); float* t_dn = (float*)(ws + WS_T_DN);
    (void)hipMemsetAsync(ws + WS_CTL, 0, CTL_ZERO_BYTES, stream);
    Args a{};
    for (int i = 0; i < 13; ++i) a.in[i] = (const float*)d_in[i];
    a.out = out; a.ws = ws;

#if MK_N_LAUNCHES == 1
    launch_mk(a, 0, N_PHASES, grid, stream);
    return;
#endif
    launch_mk(a, 0, 1, grid, stream);
    if (!(HY & 0x20)) { k_rope_tables<<<SEQ * 32 / 256, 256, 0, stream>>>(ropem, ropea); k_rmsnorm_f16<<<M / 4, 256, 0, stream>>>(x, g_pre, XN); }
    if (HY & 0x01) launch_mk(a, 1, 2, grid, stream);
    else {
        k_naive_gemm<0, 0><<<dim3((NIN + 255) / 256, M / 16), 256, 0, stream>>>((const u16*)XN, DM, w_in, DM, NIN, t_proj, nullptr, NIN);
        k_post1<<<M, 256, 0, stream>>>(t_proj, ropem, ropea, CQ, CKV, KR, QM, KM, VM, rsq_q, rsq_kv);
        k_kmean<<<NB * 16, 512, 0, stream>>>(KM, kmean);
    }
    if (HY & 0x02) launch_mk(a, 2, 3, grid, stream);
    else k_mla_up<<<M / 4, 256, 0, stream>>>(CQ, CKV, rsq_q, rsq_kv, g_q, w_qup, g_kv, w_kvup, ropea, QN, QR, KN, VA);
    if (HY & 0x40) launch_mk(a, 3, 4, grid, stream);
    else {
    k_attn_mla<<<dim3(16, 8, NB), 256, 0, stream>>>(QN, QR, KN, KR, VA, MIX);
    k_attn_moba<<<dim3(16, 8, NB), 256, 0, stream>>>(QM, KM, VM, kmean, MIX);
    }
    if (HY & 0x04) { launch_mk(a, 4, 5, grid, stream); launch_mk(a, 5, 6, grid, stream); }
    else {
        k_naive_gemm<0, 0><<<dim3(DM / 256, M / 16), 256, 0, stream>>>((const u16*)MIX, DM, w_out, DM, DM, t_out, nullptr, DM);
        k_post4<<<M, 256, 0, stream>>>(t_out, x, g_post, g_pre2, out, (u16*)XN);
    }
    if (HY & 0x08) launch_mk(a, 6, 7, grid, stream);
    else k_naive_gemm<1, 1><<<dim3(FF / 256, M / 16), 256, 0, stream>>>((const u16*)XN, DM, w_up, DM, FF, nullptr, A2, FF);
    if (HY & 0x10) { launch_mk(a, 7, 8, grid, stream); launch_mk(a, 8, 9, grid, stream); }
    else {
        k_naive_gemm<1, 0><<<dim3(DM / 256, M / 16), 256, 0, stream>>>(A2, FF, w_down, FF, DM, t_dn, nullptr, DM);
        k_post6<<<M, 256, 0, stream>>>(t_dn, g_post2, out);
    }
}
```
